# Optimizing an MI355X kernel written in HIP

```python
import jax, jax.numpy as jnp
from jax import lax
import numpy as np

D_MODEL = 2048
BATCH = 2
SEQ = 16384
DEPTH = 2

EPS = 1e-6
N_MIXERS = 2
RET_HEADS = 8
RET_DK = D_MODEL // RET_HEADS
RET_DV = 2 * RET_DK
RET_QK = RET_HEADS * RET_DK
RET_V = RET_HEADS * RET_DV
RET_PROJ = 2 * RET_QK + 2 * RET_V
RET_CHUNK = 128
RET_THETA = 10000.0
ATT_HEADS = 16
ATT_HEAD_DIM = D_MODEL // ATT_HEADS
ATT_WIDTH = ATT_HEADS * ATT_HEAD_DIM
ATT_GROUPS = ((128, 1), (512, 4), (2048, 16))
ATT_PROJ = len(ATT_GROUPS) * 3 * ATT_WIDTH
ATT_BLOCK = 128
ROT_DIM = ATT_HEAD_DIM // 4
ROPE_THETA = 500000.0
D_FF = 4 * D_MODEL

kernel_name = "hybrid_retention_dilated_attn_block"


def rms_norm(x, gain):
    x32 = x.astype(jnp.float32)
    y = x32 * lax.rsqrt(jnp.mean(x32 * x32, axis=-1, keepdims=True) + EPS)
    return (y * gain.astype(jnp.float32)).astype(x.dtype)


def modulate(h, shift, scale):
    return h * (1 + scale[:, None, :]) + shift[:, None, :]


def rope(x, positions, rot_dim, theta):
    half = rot_dim // 2
    inv_freq = jnp.power(jnp.float32(theta), -jnp.arange(half, dtype=jnp.float32) * 2.0 / rot_dim)
    ang = positions.astype(jnp.float32)[..., None] * inv_freq
    cos = jnp.cos(ang)[:, :, None, :]
    sin = jnp.sin(ang)[:, :, None, :]
    xr = x[..., :rot_dim].astype(jnp.float32)
    x1, x2 = xr[..., :half], xr[..., half:]
    rot = jnp.concatenate([x1 * cos - x2 * sin, x2 * cos + x1 * sin], axis=-1)
    return jnp.concatenate([rot.astype(x.dtype), x[..., rot_dim:]], axis=-1)


def retention_mixer(h, w_in, w_out, positions):
    B, S, _ = h.shape
    proj = h @ w_in
    q, k, v, g = jnp.split(proj, [RET_QK, 2 * RET_QK, 2 * RET_QK + RET_V], axis=-1)
    q = rope(q.reshape(B, S, RET_HEADS, RET_DK), positions, RET_DK, RET_THETA)
    k = rope(k.reshape(B, S, RET_HEADS, RET_DK), positions, RET_DK, RET_THETA) * (RET_DK ** -0.5)
    v = v.reshape(B, S, RET_HEADS, RET_DV)
    C = RET_CHUNK
    N = S // C

    def chunks(a):
        return a.astype(jnp.float32).reshape(B, N, C, RET_HEADS, -1).transpose(1, 0, 3, 2, 4)

    log_gamma = jnp.log1p(-jnp.exp2(-5.0 - jnp.arange(RET_HEADS, dtype=jnp.float32)))
    idx = jnp.arange(C, dtype=jnp.float32)
    diff = idx[:, None] - idx[None, :]
    decay = jnp.where(diff[None] >= 0,
                      jnp.exp(jnp.maximum(diff, 0.0)[None] * log_gamma[:, None, None]), 0.0)
    xi = jnp.exp((idx + 1.0)[None, :] * log_gamma[:, None])
    zeta = jnp.exp((C - 1.0 - idx)[None, :] * log_gamma[:, None])
    chunk_decay = jnp.exp(C * log_gamma)

    def step(state, qkv):
        qc, kc, vc = qkv
        scores = jnp.einsum('bhid,bhjd->bhij', qc, kc) * decay[None]
        inner = jnp.einsum('bhij,bhje->bhie', scores, vc)
        cross = jnp.einsum('bhid,bhde->bhie', qc, state) * xi[None, :, :, None]
        state = chunk_decay[None, :, None, None] * state + jnp.einsum(
            'bhjd,bhje->bhde', kc * zeta[None, :, :, None], vc)
        return state, inner + cross

    state0 = jnp.zeros((B, RET_HEADS, RET_DK, RET_DV), jnp.float32)
    _, o = lax.scan(step, state0, (chunks(q), chunks(k), chunks(v)))
    o = o.transpose(1, 0, 3, 2, 4).reshape(B, S, RET_HEADS, RET_DV)
    mu = jnp.mean(o, axis=-1, keepdims=True)
    var = jnp.mean(jnp.square(o - mu), axis=-1, keepdims=True)
    on = ((o - mu) * lax.rsqrt(var + EPS)).reshape(B, S, RET_V).astype(h.dtype)
    return (jax.nn.silu(g) * on) @ w_out


def dilated_window_group(q, k, v, dilation, n_back):
    B, S, H, dh = q.shape
    L = S // dilation
    nb = -(-L // ATT_BLOCK)
    Lp = nb * ATT_BLOCK

    def to_blocks(a):
        a = a.reshape(B, L, dilation, H, dh).transpose(0, 2, 3, 1, 4)
        a = jnp.pad(a, ((0, 0), (0, 0), (0, 0), (0, Lp - L), (0, 0)))
        return a.reshape(B, dilation, H, nb, ATT_BLOCK, dh)

    def with_prev(a):
        prev = jnp.pad(a, ((0, 0), (0, 0), (0, 0), (1, 0), (0, 0), (0, 0)))[:, :, :, :-1]
        return jnp.concatenate([prev, a], axis=-2)

    qb = to_blocks(q)
    kw = with_prev(to_blocks(k))
    vw = with_prev(to_blocks(v))
    s = jnp.einsum('brhnid,brhnjd->brhnij', qb, kw,
                   preferred_element_type=jnp.float32) * (dh ** -0.5)
    i = jnp.arange(ATT_BLOCK)[:, None]
    j = jnp.arange(2 * ATT_BLOCK)[None, :]
    dist = ATT_BLOCK + i - j
    key_idx = jnp.arange(nb)[:, None, None] * ATT_BLOCK - ATT_BLOCK + j[None]
    valid = (dist >= 0)[None] & (dist <= n_back)[None] & (key_idx >= 0)
    s = jnp.where(valid, s, -jnp.inf)
    m = jnp.max(s, axis=-1, keepdims=True)
    p = jnp.exp(s - m)
    l = jnp.sum(p, axis=-1)
    o = jnp.einsum('brhnij,brhnjd->brhnid', p.astype(vw.dtype), vw,
                   preferred_element_type=jnp.float32) / l[..., None]
    lse = m[..., 0] + jnp.log(l)
    o = o.reshape(B, dilation, H, Lp, dh)[:, :, :, :L].transpose(0, 3, 1, 2, 4).reshape(B, S, H, dh)
    lse = lse.reshape(B, dilation, H, Lp)[..., :L].transpose(0, 3, 1, 2).reshape(B, S, H)
    return o, lse


def dilated_attention_mixer(h, w_in, w_out, positions):
    B, S, _ = h.shape
    proj = (h @ w_in).reshape(B, S, len(ATT_GROUPS), 3, ATT_HEADS, ATT_HEAD_DIM)
    outs, lses = [], []
    for gi, (window, dilation) in enumerate(ATT_GROUPS):
        q = rope(proj[:, :, gi, 0], positions, ROT_DIM, ROPE_THETA)
        k = rope(proj[:, :, gi, 1], positions, ROT_DIM, ROPE_THETA)
        o, lse = dilated_window_group(q, k, proj[:, :, gi, 2], dilation, window // dilation)
        outs.append(o)
        lses.append(lse)
    wts = jax.nn.softmax(jnp.stack(lses, axis=0), axis=0)
    o = jnp.sum(wts[..., None] * jnp.stack(outs, axis=0), axis=0)
    return o.reshape(B, S, ATT_WIDTH).astype(h.dtype) @ w_out


def squared_relu_mlp(h, w1, w2):
    return jnp.square(jax.nn.relu(h @ w1)) @ w2


def setup_inputs(seed: int = 0) -> dict:
    key = jax.random.key(seed)
    ks = jax.random.split(key, 16)
    n_ret = (DEPTH + 1) // 2
    n_att = DEPTH // 2
    f32 = jnp.float32
    x = jax.random.normal(ks[0], (BATCH, SEQ, D_MODEL), f32)
    c = jax.random.normal(ks[1], (BATCH, D_MODEL), f32)
    offsets = jax.random.randint(ks[2], (BATCH, 1), 0, 1024, dtype=jnp.int32)
    positions = (jnp.arange(SEQ, dtype=jnp.int32)[None, :] + offsets).astype(jnp.int32)
    ada_w = jax.random.normal(ks[3], (DEPTH, D_MODEL, 6 * D_MODEL), f32) * (0.5 * D_MODEL ** -0.5)
    ada_b = 0.02 * jax.random.normal(ks[4], (DEPTH, 6 * D_MODEL), f32)
    norm_mix = 1.0 + 0.02 * jax.random.normal(ks[5], (DEPTH, D_MODEL), f32)
    norm_mlp = 1.0 + 0.02 * jax.random.normal(ks[6], (DEPTH, D_MODEL), f32)
    ret_w_in = jax.random.normal(ks[7], (n_ret, D_MODEL, RET_PROJ), f32) * (D_MODEL ** -0.5)
    ret_w_out = jax.random.normal(ks[8], (n_ret, RET_V, D_MODEL), f32) * (RET_V ** -0.5)
    att_w_in = jax.random.normal(ks[9], (n_att, D_MODEL, ATT_PROJ), f32) * (D_MODEL ** -0.5)
    att_w_out = jax.random.normal(ks[10], (n_att, ATT_WIDTH, D_MODEL), f32) * (ATT_WIDTH ** -0.5)
    mlp_w1 = jax.random.normal(ks[11], (DEPTH, D_MODEL, D_FF), f32) * (D_MODEL ** -0.5)
    mlp_w2 = jax.random.normal(ks[12], (DEPTH, D_FF, D_MODEL), f32) * (D_FF ** -0.5)
    final_norm = 1.0 + 0.02 * jax.random.normal(ks[13], (D_MODEL,), f32)
    return {"x": x, "c": c, "positions": positions, "ada_w": ada_w, "ada_b": ada_b,
            "norm_mix": norm_mix, "norm_mlp": norm_mlp, "ret_w_in": ret_w_in,
            "ret_w_out": ret_w_out, "att_w_in": att_w_in, "att_w_out": att_w_out,
            "mlp_w1": mlp_w1, "mlp_w2": mlp_w2, "final_norm": final_norm}


def reference(x, c, positions, ada_w, ada_b, norm_mix, norm_mlp, ret_w_in, ret_w_out,
              att_w_in, att_w_out, mlp_w1, mlp_w2, final_norm):
    c_act = jax.nn.silu(c)
    for i in range(DEPTH):
        mod = c_act @ ada_w[i] + ada_b[i]
        sh1, sc1, g1, sh2, sc2, g2 = jnp.split(mod, 6, axis=-1)
        h = modulate(rms_norm(x, norm_mix[i]), sh1, sc1)
        if i % N_MIXERS == 0:
            y = retention_mixer(h, ret_w_in[i // N_MIXERS], ret_w_out[i // N_MIXERS], positions)
        else:
            y = dilated_attention_mixer(h, att_w_in[i // N_MIXERS], att_w_out[i // N_MIXERS], positions)
        x = x + g1[:, None, :] * y
        h = modulate(rms_norm(x, norm_mlp[i]), sh2, sc2)
        x = x + g2[:, None, :] * squared_relu_mlp(h, mlp_w1[i], mlp_w2[i])
    return rms_norm(x, final_norm)
```

```cpp
#include <hip/hip_runtime.h>
#include <hip/hip_cooperative_groups.h>
#include <cstdio>
#include <cmath>
namespace cg = cooperative_groups;

#define LAS __attribute__((address_space(3)))
typedef unsigned short bf16_t;
typedef short bf16x8 __attribute__((ext_vector_type(8)));
typedef float f32x4 __attribute__((ext_vector_type(4)));
typedef float f32x2 __attribute__((ext_vector_type(2)));
typedef unsigned u32x4 __attribute__((ext_vector_type(4)));
typedef unsigned u32x2 __attribute__((ext_vector_type(2)));

constexpr int D = 2048, SEQ = 16384, NB = 2, T = NB * SEQ, DFF = 8192;
constexpr int RPROJ = 12288, APROJ = 18432, RV = 4096;
constexpr float EPS = 1e-6f;
constexpr int NT = 512;
constexpr int LDS_MISC = 137216;
constexpr int LDS_BYTES = LDS_MISC + 256;

constexpr size_t WS_W      = 0;
constexpr size_t W_BYTES   = 150994944;
constexpr size_t WS_CSR    = WS_W + W_BYTES;
constexpr size_t WS_CSRT   = WS_CSR + (size_t)2 * SEQ * 128 * 8;
constexpr size_t WS_CSA    = WS_CSRT + (size_t)2 * SEQ * 128 * 8;
constexpr size_t WS_MODP   = WS_CSA + (size_t)2 * SEQ * 16 * 8;
constexpr size_t WS_MOD    = WS_MODP + (size_t)16 * 4 * 12288 * 4;
constexpr size_t WS_STATS  = WS_MOD + (size_t)4 * 12288 * 4;
constexpr size_t WS_LSE    = WS_STATS + (size_t)SEQ * 128 * 4;
constexpr size_t WS_L2G    = WS_LSE + (size_t)3 * SEQ * 16 * 4;
constexpr size_t WS_BAR    = WS_L2G + 256;
constexpr size_t BAR_BYTES = 16384;
constexpr size_t WS_H      = WS_BAR + BAR_BYTES;
constexpr size_t WS_ACT    = WS_H + (size_t)T * D * 2;
constexpr size_t ACT_BYTES = 671088640;
constexpr size_t WS_END    = WS_ACT + ACT_BYTES;
constexpr size_t A_AP = 0;
constexpr size_t A_BP = A_AP + (size_t)512 * 256 * 512;
constexpr size_t A_KT = A_BP + (size_t)512 * 512 * 512;
constexpr size_t A_KZ = A_KT + (size_t)512 * 65536;
constexpr size_t A_O  = A_KT;
constexpr size_t A_GG = A_KZ + (size_t)512 * 65536;
constexpr size_t W0_RIN = 0, W0_ROUT = W0_RIN + (size_t)RPROJ * D, W0_1 = W0_ROUT + (size_t)D * RV, W0_2 = W0_1 + (size_t)DFF * D;
constexpr size_t W1_AIN = 0, W1_AOUT = W1_AIN + (size_t)APROJ * D, W1_1 = W1_AOUT + (size_t)D * D, W1_2 = W1_1 + (size_t)DFF * D;

struct Args {
    const float* x; const float* c; const int* pos; const float* ada_w; const float* ada_b; const float* norm_mix; const float* norm_mlp;
    const float* ret_w_in; const float* ret_w_out; const float* att_w_in; const float* att_w_out; const float* mlp_w1; const float* mlp_w2; const float* final_norm;
    float* out; unsigned char* ws;
    float invf_ret[128]; float invf_att[16]; float l2g[8];
};

__device__ __forceinline__ unsigned cvt_pk_bf16(float lo, float hi) { unsigned r; asm volatile("v_cvt_pk_bf16_f32 %0, %1, %2" : "=v"(r) : "v"(lo), "v"(hi)); return r; }
__device__ __forceinline__ float bf_lo(unsigned w) { return __uint_as_float(w << 16); }
__device__ __forceinline__ float bf_hi(unsigned w) { return __uint_as_float(w & 0xffff0000u); }
__device__ __forceinline__ float wave_sum(float v) {
#pragma unroll
    for (int o = 32; o >= 1; o >>= 1) v += __shfl_xor(v, o);
    return v;
}
__device__ __forceinline__ float silu_f(float v) { return v / (1.0f + __expf(-v)); }


#define XB_TMO      128
#define XB_XCNT(j)  (256  + 64 * (j))
#define XB_XSUB(j)  (1280 + 64 * (j))
#define XB_XGEN(j)  (2304 + 64 * (j))
#define XB_TOP      3328
#define XB_TOPGEN   3392
#define XCD_BAR_WORDS 3456
#define XB_SPIN_CAP (1u << 18)
__device__ __forceinline__ unsigned xb_ld(unsigned* p)              { return __hip_atomic_load(p, __ATOMIC_RELAXED, __HIP_MEMORY_SCOPE_AGENT); }
__device__ __forceinline__ unsigned xb_add(unsigned* p, unsigned v) { return __hip_atomic_fetch_add(p, v, __ATOMIC_RELAXED, __HIP_MEMORY_SCOPE_AGENT); }
__device__ __forceinline__ unsigned xb_xcc_id() { return (unsigned)__builtin_amdgcn_s_getreg((3 << 11) | 20) & 0xFu; }
#define XB_SPIN(cond, bar) do { unsigned _sp = 0; while (cond) { __builtin_amdgcn_s_sleep(1); \
    if ((++_sp & 255u) == 0u) { if (xb_ld(&(bar)[XB_TMO])) break; if (_sp > XB_SPIN_CAP) { atomicAdd(&(bar)[XB_TMO], 1u); break; } } } } while (0)
struct XcdBarrier { unsigned* bar; unsigned x; volatile LAS unsigned* st; };
__device__ __forceinline__ XcdBarrier xcd_barrier_post(unsigned* bar, volatile LAS unsigned* st) {
    XcdBarrier b; b.bar = bar; b.x = xb_xcc_id(); b.st = st;
    if (threadIdx.x == 0) (void)xb_add(&bar[XB_XCNT(b.x)], 1u);
    return b;
}
__device__ __forceinline__ void xcd_barrier_complete(unsigned* bar, unsigned x, unsigned& nloc, unsigned& nx) {
    const unsigned G = gridDim.x * gridDim.y * gridDim.z;
    unsigned sum, cnt, mine, sp = 0u;
    for (;;) {
        sum = 0u; cnt = 0u; mine = 0u;
#pragma unroll
        for (unsigned j = 0; j < 16; ++j) { const unsigned c = xb_ld(&bar[XB_XCNT(j)]); sum += c; cnt += (c > 0u) ? 1u : 0u; mine = (j == x) ? c : mine; }
        if (sum == G) break;
        __builtin_amdgcn_s_sleep(1);
        if ((++sp & 255u) == 0u) { if (xb_ld(&bar[XB_TMO])) break; if (sp > XB_SPIN_CAP) { atomicAdd(&bar[XB_TMO], 1u); break; } }
    }
    nloc = mine > 0u ? mine : 1u; nx = cnt > 0u ? cnt : 1u;
}
__device__ __forceinline__ void xcd_barrier(const XcdBarrier& b) {
    asm volatile("s_waitcnt vmcnt(0)" ::: "memory");
    __syncthreads();
    if (threadIdx.x == 0) {
        unsigned* bar = b.bar;
        __builtin_amdgcn_s_waitcnt(0);
        unsigned nloc = b.st[0], nx = b.st[1];
        if (nloc == 0u) { xcd_barrier_complete(bar, b.x, nloc, nx); b.st[0] = nloc; b.st[1] = nx; }
        const unsigned old = xb_add(&bar[XB_XSUB(b.x)], 1u);
        const unsigned gen = old / nloc;
        if (old + 1u == (gen + 1u) * nloc) {
            __builtin_amdgcn_fence(__ATOMIC_RELEASE, "agent");
            asm volatile("s_waitcnt vmcnt(0)" ::: "memory");
            const unsigned og = xb_add(&bar[XB_TOP], 1u);
            const unsigned tg = og / nx;
            if (og + 1u == (tg + 1u) * nx) xb_add(&bar[XB_TOPGEN], 1u);
            else XB_SPIN(xb_ld(&bar[XB_TOPGEN]) == tg, bar);
            __builtin_amdgcn_fence(__ATOMIC_ACQUIRE, "agent");
            xb_add(&bar[XB_XGEN(b.x)], 1u);
            asm volatile("s_waitcnt vmcnt(0)" ::: "memory");
        } else {
            XB_SPIN(xb_ld(&bar[XB_XGEN(b.x)]) == gen, bar);
            __builtin_amdgcn_fence(__ATOMIC_ACQUIRE, "agent");
            asm volatile("s_waitcnt vmcnt(0)" ::: "memory");
        }
    }
    __syncthreads();
}

namespace pg8 {
constexpr int BM = 256, BK = 64, HALF = 128, HTB = HALF * BK * 2, STAGE_BYTES = 8 * HTB, NXCD = 8, WGM = 8;
__device__ __forceinline__ int lds_byte(int r, int c) { const int st = (r >> 4) * 2 + (c >> 5), rr = r & 15, cc = c & 31, ob = rr * 64 + cc * 2; return st * 1024 + (ob ^ (((ob >> 9) & 1) << 5)); }
__device__ __forceinline__ void stage_rc(int b, int& R, int& C) { const int st = b / 1024, sb = b % 1024, swz = sb ^ (((sb >> 9) & 1) << 5); R = (st >> 1) * 16 + swz / 64; C = (st & 1) * 32 + (swz % 64) / 2; }
__device__ __forceinline__ int perm32(int rho) { const int n = rho >> 4, i = rho & 15; return 8 * (i >> 2) + 4 * n + (i & 3); }

struct Unit { unsigned aoff, boff, coff; int pm, pn; };
struct Gemm { const bf16_t* A; const bf16_t* Bt; int lda, ldb, K; };

template <class Map> struct Sched {
    int nM, nN, nwg, G, c; Map map;
    __device__ __forceinline__ bool next(int i, Unit& u) const {
        const long L = (long)i * G + c; if (L >= nwg) return false;
        int wgid = (int)L; { const int q = nwg / NXCD, r = nwg % NXCD, xcd = wgid % NXCD, off = wgid / NXCD; wgid = (xcd < r ? xcd * (q + 1) : r * (q + 1) + (xcd - r) * q) + off; }
        const int nig = WGM * nN, gid = wgid / nig, fm = gid * WGM, gsz = (nM - fm) < WGM ? (nM - fm) : WGM;
        u.pm = fm + ((wgid % nig) % gsz); u.pn = (wgid % nig) / gsz;
        map(u.pm, u.pn, u);
        return true;
    }
};
template <class Map> __device__ __forceinline__ Sched<Map> mk_sched(int nM, int nN, Map m) { Sched<Map> s; s.nM = nM; s.nN = nN; s.nwg = nM * nN; s.G = gridDim.x; s.c = blockIdx.x; s.map = m; return s; }
constexpr unsigned MB1 = 1048576u;
struct MapRetQK { unsigned tile; __device__ __forceinline__ void operator()(int pm, int pn, Unit& u) const { u.aoff = pm * MB1; u.boff = pn * MB1; u.coff = (unsigned)(pn * 64 + pm) * tile; } };
struct MapKzT { __device__ __forceinline__ void operator()(int pm, int pn, Unit& u) const { u.aoff = pm * MB1; u.boff = pn * MB1; u.coff = (unsigned)(pm * 64 + pn) * 65536u; } };
struct MapVT0 { __device__ __forceinline__ void operator()(int pm, int pn, Unit& u) const { u.aoff = pm * MB1; u.boff = pn * MB1; u.coff = 256u + (unsigned)((pm >> 1) * 64 + pn) * 262144u + (unsigned)(pm & 1) * 131072u; } };
struct MapG { __device__ __forceinline__ void operator()(int pm, int pn, Unit& u) const { u.aoff = pm * MB1; u.boff = pn * MB1; u.coff = (unsigned)pm * (256u * 4096u) + pn * 256u; } };
struct MapP { __device__ __forceinline__ void operator()(int pm, int pn, Unit& u) const { u.aoff = pm * 262144u; u.boff = pm * 131072u; u.coff = 256u + pm * 131072u; } };
struct MapU { __device__ __forceinline__ void operator()(int pm, int pn, Unit& u) const { u.aoff = 512u + pm * 262144u; u.boff = (unsigned)(pm >> 1) * 131072u; u.coff = pm * 131072u; } };
struct MapO { __device__ __forceinline__ void operator()(int pm, int pn, Unit& u) const { u.aoff = pm * 262144u; u.boff = pm * 524288u + pn * 262144u; u.coff = (unsigned)(pm >> 6) * 512u + (unsigned)(pm & 63) * (256u * 4096u) + pn * 256u; } };
struct MapOut0 { __device__ __forceinline__ void operator()(int pm, int pn, Unit& u) const { u.aoff = pm * (2u * MB1); u.boff = pn * (2u * MB1); u.coff = 0; } };
struct MapMlp1 { __device__ __forceinline__ void operator()(int pm, int pn, Unit& u) const { u.aoff = pm * MB1; u.boff = pn * MB1; u.coff = (unsigned)pm * (256u * 8192u) + pn * 256u; } };
struct MapMlp2 { __device__ __forceinline__ void operator()(int pm, int pn, Unit& u) const { u.aoff = pm * (4u * MB1); u.boff = pn * (4u * MB1); u.coff = 0; } };
struct MapAttQK { int sh, ld; __device__ __forceinline__ void operator()(int pm, int pn, Unit& u) const { u.aoff = (unsigned)(pm >> sh) * 4096u + ((unsigned)(pm & ((1 << sh) - 1)) * MB1 << ld); u.boff = pn * MB1; u.coff = (unsigned)pm * (256u * 2048u) + pn * 256u; } };
struct MapAttVT { int sh, ld; __device__ __forceinline__ void operator()(int pm, int pn, Unit& u) const { u.aoff = pm * MB1; u.boff = (unsigned)(pn >> sh) * 4096u + ((unsigned)(pn & ((1 << sh) - 1)) * MB1 << ld); u.coff = (unsigned)pm * (256u * 16384u) + pn * 256u; } };
struct MapOut1 { __device__ __forceinline__ void operator()(int pm, int pn, Unit& u) const { u.aoff = pm * MB1; u.boff = pn * MB1; u.coff = 0; } };

template <class Epi, class Map>
__device__ __forceinline__ void gemm_phase(LAS unsigned char* lds, const Gemm g, const Sched<Map>& S, const Epi& E) {
    int tid_ = threadIdx.x; asm volatile("" : "+v"(tid_));
    const int tid = tid_, wid = __builtin_amdgcn_readfirstlane(tid >> 6), lane = tid & 63, wr = wid >> 2, wc = wid & 3, fr = lane & 15, fq = lane >> 4;
    const int K = g.K, nt = K / BK;
    unsigned voffA[2], voffB[2];
#pragma unroll
    for (int i = 0; i < 2; ++i) { int R, C; stage_rc(tid * 16 + i * 8192, R, C); const int Rb = Epi::PERM ? ((R & ~31) + perm32(R & 31)) : R;
        voffA[i] = (unsigned)(R * g.lda + C) * 2u; voffB[i] = (unsigned)(Rb * g.ldb + C) * 2u; }
    const size_t kstep = (size_t)(BK * 2);
    const size_t hstepA = (size_t)HALF * g.lda * 2, hstepB = (size_t)HALF * g.ldb * 2;
    const unsigned ldsw = (unsigned)wid * 1024u;
    const int aoff = lds_byte(wr * 64 + fr, fq * 8), boff = lds_byte(wc * 32 + fr, fq * 8);
#define PG8_SA(b, h) (((b) * 2 + (h)) * HTB)
#define PG8_SB(b, h) ((4 + (b) * 2 + (h)) * HTB)
#define PG8_STAGE(bufoff, gbase, voff) do { _Pragma("unroll") for (int _i = 0; _i < 2; ++_i) \
        __builtin_amdgcn_global_load_lds((const unsigned*)((const char*)(gbase) + (voff)[_i]), (LAS unsigned*)(lds + (bufoff) + ldsw + _i * 8192), 16, 0, 0); } while (0)
#define PG8_LDA(dst, b, h) do { _Pragma("unroll") for (int m = 0; m < 4; ++m) _Pragma("unroll") for (int k = 0; k < 2; ++k) dst[m][k] = *(const LAS bf16x8*)(lds + PG8_SA(b, h) + aoff + m * 2048 + k * 1024); } while (0)
#define PG8_LDB(dst, b, h) do { _Pragma("unroll") for (int n = 0; n < 2; ++n) _Pragma("unroll") for (int k = 0; k < 2; ++k) dst[n][k] = *(const LAS bf16x8*)(lds + PG8_SB(b, h) + boff + n * 2048 + k * 1024); } while (0)
#define PG8_MMA(ai, bj, At, Bt) do { __builtin_amdgcn_s_setprio(1); _Pragma("unroll") for (int m = 0; m < 4; ++m) _Pragma("unroll") for (int n = 0; n < 2; ++n) _Pragma("unroll") for (int k = 0; k < 2; ++k) \
        acc[ai][bj][m][n] = __builtin_amdgcn_mfma_f32_16x16x32_bf16(Bt[n][k], At[m][k], acc[ai][bj][m][n], 0, 0, 0); __builtin_amdgcn_s_setprio(0); } while (0)
#define PG8_WAIT_V(n) asm volatile("s_waitcnt vmcnt(" #n ")" ::: "memory")
#define PG8_WAIT_L(n) asm volatile("s_waitcnt lgkmcnt(" #n ")" ::: "memory")
#define PG8_BAR __builtin_amdgcn_s_barrier()
#define PG8_SCHED __builtin_amdgcn_sched_barrier(0)
    Unit cur, nxt; int ui = 0;
    if (!S.next(0, cur)) return;
    f32x4 acc[2][2][4][2];
#pragma unroll
    for (int a = 0; a < 2; ++a)
#pragma unroll
        for (int b = 0; b < 2; ++b)
#pragma unroll
            for (int m = 0; m < 4; ++m)
#pragma unroll
                for (int n = 0; n < 2; ++n) acc[a][b][m][n] = (f32x4){0.f, 0.f, 0.f, 0.f};
    bf16x8 At[4][2], B0[2][2], B1[2][2];
    const char* cA = (const char*)g.A + cur.aoff; const char* cB = (const char*)g.Bt + cur.boff;
    PG8_STAGE(PG8_SB(0, 0), cB, voffB); PG8_STAGE(PG8_SB(0, 1), cB + hstepB, voffB); PG8_STAGE(PG8_SA(0, 0), cA, voffA); PG8_STAGE(PG8_SA(0, 1), cA + hstepA, voffA);
    if (wr == 1) PG8_BAR;
    PG8_WAIT_V(2); PG8_BAR;
    PG8_STAGE(PG8_SB(1, 0), cB + kstep, voffB); PG8_STAGE(PG8_SA(1, 0), cA + kstep, voffA); PG8_STAGE(PG8_SB(1, 1), cB + hstepB + kstep, voffB);
    PG8_WAIT_V(6); PG8_BAR;
#pragma unroll 1
    for (;;) {
        const bool has_next = S.next(ui + 1, nxt);
        const char* nA = has_next ? (const char*)g.A + nxt.aoff : cA; const char* nB = has_next ? (const char*)g.Bt + nxt.boff : cB;
#pragma unroll 1
        for (int t = 0; t < nt; t += 2) {
            const bool last = (t == nt - 2);
            const char* a1 = cA + (size_t)(t + 1) * kstep;
            const char* a2 = last ? nA : cA + (size_t)(t + 2) * kstep; const char* b2 = last ? nB : cB + (size_t)(t + 2) * kstep;
            const char* a3 = a2 + kstep; const char* b3 = b2 + kstep;
            PG8_LDB(B0, 0, 0); PG8_LDB(B1, 0, 1); PG8_SCHED; PG8_LDA(At, 0, 0); PG8_STAGE(PG8_SA(1, 1), a1 + hstepA, voffA);
            PG8_WAIT_V(8); PG8_WAIT_L(0); PG8_BAR; PG8_MMA(0, 0, At, B0); PG8_MMA(0, 1, At, B1); PG8_BAR; PG8_SCHED;
            PG8_LDA(At, 0, 1); PG8_STAGE(PG8_SB(0, 0), b2, voffB); PG8_STAGE(PG8_SB(0, 1), b2 + hstepB, voffB); PG8_STAGE(PG8_SA(0, 0), a2, voffA);
            PG8_WAIT_V(8); PG8_WAIT_L(0); PG8_BAR; PG8_MMA(1, 0, At, B0); PG8_MMA(1, 1, At, B1); PG8_BAR; PG8_SCHED;
            PG8_LDB(B0, 1, 0); PG8_LDB(B1, 1, 1); PG8_SCHED; PG8_LDA(At, 1, 0); PG8_STAGE(PG8_SA(0, 1), a2 + hstepA, voffA);
            PG8_WAIT_V(8); PG8_WAIT_L(0); PG8_BAR; PG8_MMA(0, 0, At, B0); PG8_MMA(0, 1, At, B1); PG8_BAR; PG8_SCHED;
            PG8_LDA(At, 1, 1); PG8_STAGE(PG8_SB(1, 0), b3, voffB); PG8_STAGE(PG8_SB(1, 1), b3 + hstepB, voffB); PG8_STAGE(PG8_SA(1, 0), a3, voffA);
            PG8_WAIT_V(8); PG8_WAIT_L(0); PG8_BAR; PG8_MMA(1, 0, At, B0); PG8_MMA(1, 1, At, B1); PG8_BAR; PG8_SCHED;
        }
        if (wr == 0) PG8_BAR;
        E(acc, cur, wr, wc, fr, fq);
        if (!has_next) break;
#pragma unroll
        for (int a = 0; a < 2; ++a)
#pragma unroll
            for (int b = 0; b < 2; ++b)
#pragma unroll
                for (int m = 0; m < 4; ++m)
#pragma unroll
                    for (int n = 0; n < 2; ++n) acc[a][b][m][n] = (f32x4){0.f, 0.f, 0.f, 0.f};
        cur = nxt; cA = nA; cB = nB; ++ui;
        if (wr == 1) PG8_BAR;
    }
    PG8_WAIT_V(0);
    PG8_BAR;
#undef PG8_SA
#undef PG8_SB
#undef PG8_STAGE
#undef PG8_LDA
#undef PG8_LDB
#undef PG8_MMA
#undef PG8_WAIT_V
#undef PG8_WAIT_L
#undef PG8_BAR
#undef PG8_SCHED
}

typedef f32x4 Acc[2][2][4][2];

template <int ACT> struct EpiBf16 {
    static constexpr bool PERM = true;
    bf16_t* O; int ldc;
    __device__ __forceinline__ void operator()(const Acc& acc, const Unit& u, int wr, int wc, int fr, int fq) const {
        asm volatile("" : "+v"(fr), "+v"(fq));
        bf16_t* base = O + u.coff + (size_t)(wr * 64 + fr) * ldc + wc * 32 + 8 * fq;
#pragma unroll
        for (int ai = 0; ai < 2; ++ai)
#pragma unroll
            for (int m = 0; m < 4; ++m) { bf16_t* rowp = base + (size_t)(ai * HALF + m * 16) * ldc;
#pragma unroll
                for (int bj = 0; bj < 2; ++bj) { f32x4 v0 = acc[ai][bj][m][0], v1 = acc[ai][bj][m][1];
                    if (ACT == 1) {
#pragma unroll
                        for (int j = 0; j < 4; ++j) { v0[j] = silu_f(v0[j]); v1[j] = silu_f(v1[j]); } }
                    if (ACT == 2) {
#pragma unroll
                        for (int j = 0; j < 4; ++j) { const float a = fmaxf(v0[j], 0.f), b = fmaxf(v1[j], 0.f); v0[j] = a * a; v1[j] = b * b; } }
                    u32x4 w; w.x = cvt_pk_bf16(v0[0], v0[1]); w.y = cvt_pk_bf16(v0[2], v0[3]); w.z = cvt_pk_bf16(v1[0], v1[1]); w.w = cvt_pk_bf16(v1[2], v1[3]);
                    *(u32x4*)(rowp + bj * HALF) = w; } }
    }
};
struct EpiRes {
    static constexpr bool PERM = false;
    const float* base; float* out; const float* gate; int gate_bstride;
    __device__ __forceinline__ void operator()(const Acc& acc, const Unit& u, int wr, int wc, int fr, int fq) const {
        asm volatile("" : "+v"(fr), "+v"(fq));
        const int row0 = u.pm * BM + wr * 64 + fr, col0 = u.pn * BM + wc * 32 + 4 * fq;
        const float* gp = gate + (size_t)(u.pm >> 6) * gate_bstride + col0;
        f32x4 gv[2][2];
#pragma unroll
        for (int bj = 0; bj < 2; ++bj)
#pragma unroll
            for (int n = 0; n < 2; ++n) gv[bj][n] = *(const f32x4*)(gp + bj * HALF + n * 16);
#pragma unroll
        for (int aim = 0; aim < 4; ++aim) { const int ai = aim >> 1, m0 = (aim & 1) * 2;
            f32x4 bs[2][2][2];
#pragma unroll
            for (int mm = 0; mm < 2; ++mm) { const size_t off = (size_t)(row0 + ai * HALF + (m0 + mm) * 16) * D + col0;
#pragma unroll
                for (int bj = 0; bj < 2; ++bj)
#pragma unroll
                    for (int n = 0; n < 2; ++n) bs[mm][bj][n] = *(const f32x4*)(base + off + bj * HALF + n * 16); }
#pragma unroll
            for (int mm = 0; mm < 2; ++mm) { const size_t off = (size_t)(row0 + ai * HALF + (m0 + mm) * 16) * D + col0;
#pragma unroll
                for (int bj = 0; bj < 2; ++bj)
#pragma unroll
                    for (int n = 0; n < 2; ++n) *(f32x4*)(out + off + bj * HALF + n * 16) = bs[mm][bj][n] + gv[bj][n] * acc[ai][bj][m0 + mm][n]; }
            asm volatile("" ::: "memory"); }
    }
};
struct EpiY {
    static constexpr bool PERM = true;
    bf16_t* Y; const float* gate; int gate_bstride;
    __device__ __forceinline__ void operator()(const Acc& acc, const Unit& u, int wr, int wc, int fr, int fq) const {
        asm volatile("" : "+v"(fr), "+v"(fq));
        const int col0 = u.pn * BM + wc * 32 + 8 * fq;
        const float* gp = gate + (size_t)(u.pm >> 6) * gate_bstride + col0;
        f32x4 gv[2][2];
#pragma unroll
        for (int bj = 0; bj < 2; ++bj) { gv[bj][0] = *(const f32x4*)(gp + bj * HALF); gv[bj][1] = *(const f32x4*)(gp + bj * HALF + 4); }
        bf16_t* base = Y + (size_t)(u.pm * BM + wr * 64 + fr) * D + col0;
#pragma unroll
        for (int ai = 0; ai < 2; ++ai)
#pragma unroll
            for (int m = 0; m < 4; ++m) { bf16_t* rowp = base + (size_t)(ai * HALF + m * 16) * D;
#pragma unroll
                for (int bj = 0; bj < 2; ++bj) { const f32x4 v0 = acc[ai][bj][m][0] * gv[bj][0], v1 = acc[ai][bj][m][1] * gv[bj][1];
                    u32x4 w; w.x = cvt_pk_bf16(v0[0], v0[1]); w.y = cvt_pk_bf16(v0[2], v0[3]); w.z = cvt_pk_bf16(v1[0], v1[1]); w.w = cvt_pk_bf16(v1[2], v1[3]);
                    *(u32x4*)(rowp + bj * HALF) = w; } }
    }
};
struct EpiRetQK {
    static constexpr bool PERM = true;
    bf16_t* O; int ldc; const f32x4* cs;   int mode;   const float* l2g; bf16_t* KZ;
    __device__ __forceinline__ void operator()(const Acc& acc, const Unit& u, int wr, int wc, int fr, int fq) const {
        asm volatile("" : "+v"(fr), "+v"(fq));
        const float lg = l2g[u.pn];
#pragma unroll
        for (int ai = 0; ai < 2; ++ai)
#pragma unroll
            for (int m = 0; m < 4; ++m) {
                const int row_in = ai * HALF + wr * 64 + m * 16 + fr, s = u.pm * BM + row_in;
                const float rs = mode == 0 ? exp2f((float)(row_in + 1) * lg) : 0.0625f;
                const f32x4* cp = cs + ((size_t)s * 128 + wc * 32 + 8 * fq) / 2;
                f32x4 t[4];
#pragma unroll
                for (int i = 0; i < 4; ++i) t[i] = cp[i];
                float o1[8], o2[8];
#pragma unroll
                for (int n = 0; n < 2; ++n)
#pragma unroll
                    for (int j = 0; j < 4; ++j) { const int e = n * 4 + j; const float co = t[e >> 1][(e & 1) * 2], si = t[e >> 1][(e & 1) * 2 + 1];
                        const float x1 = acc[ai][0][m][n][j], x2 = acc[ai][1][m][n][j];
                        o1[e] = (x1 * co - x2 * si) * rs; o2[e] = (x2 * co + x1 * si) * rs; }
                bf16_t* rowp = O + u.coff + (size_t)row_in * ldc + wc * 32 + 8 * fq;
                u32x4 w; w.x = cvt_pk_bf16(o1[0], o1[1]); w.y = cvt_pk_bf16(o1[2], o1[3]); w.z = cvt_pk_bf16(o1[4], o1[5]); w.w = cvt_pk_bf16(o1[6], o1[7]);
                *(u32x4*)rowp = w;
                w.x = cvt_pk_bf16(o2[0], o2[1]); w.y = cvt_pk_bf16(o2[2], o2[3]); w.z = cvt_pk_bf16(o2[4], o2[5]); w.w = cvt_pk_bf16(o2[6], o2[7]);
                *(u32x4*)(rowp + HALF) = w;
                if (mode == 1) {
                    const float z = exp2f((float)(255 - row_in) * lg);
                    const int p = fr & 3;
                    bf16_t* kz = KZ + u.coff + (size_t)(wc * 32 + 8 * fq + p) * 256 + (row_in - p);
#pragma unroll
                    for (int blk = 0; blk < 4; ++blk) {
                        const float* ov = (blk < 2) ? o1 : o2; const int e0 = (blk & 1) * 4;
                        const unsigned P0 = cvt_pk_bf16(ov[e0] * z, ov[e0 + 1] * z), P1 = cvt_pk_bf16(ov[e0 + 2] * z, ov[e0 + 3] * z);
                        const unsigned Q0 = (unsigned)__builtin_amdgcn_mov_dpp((int)P0, 0xB1, 0xF, 0xF, true), Q1 = (unsigned)__builtin_amdgcn_mov_dpp((int)P1, 0xB1, 0xF, 0xF, true);
                        const unsigned R0 = (p & 1) ? ((Q0 >> 16) | (P0 & 0xffff0000u)) : ((P0 & 0xffffu) | (Q0 << 16));
                        const unsigned R1 = (p & 1) ? ((Q1 >> 16) | (P1 & 0xffff0000u)) : ((P1 & 0xffffu) | (Q1 << 16));
                        const unsigned S0 = (unsigned)__builtin_amdgcn_mov_dpp((int)R0, 0x4E, 0xF, 0xF, true), S1 = (unsigned)__builtin_amdgcn_mov_dpp((int)R1, 0x4E, 0xF, 0xF, true);
                        u32x2 w; w.x = (p & 2) ? S1 : R0; w.y = (p & 2) ? R1 : S0;
                        *(u32x2*)(kz + (size_t)((blk >> 1) * HALF + e0) * 256) = w;
                    }
                }
            }
    }
};
struct EpiKzT {
    static constexpr bool PERM = true;
    bf16_t* O; const f32x4* csT;   const float* l2g;
    __device__ __forceinline__ void operator()(const Acc& acc, const Unit& u, int wr, int wc, int fr, int fq) const {
        asm volatile("" : "+v"(fr), "+v"(fq));
        const float lg = l2g[u.pm];
#pragma unroll
        for (int bj = 0; bj < 2; ++bj) {
            const int tok0 = bj * HALF + wc * 32 + 8 * fq;
            float zs[8];
#pragma unroll
            for (int e = 0; e < 8; ++e) zs[e] = 0.0625f * exp2f((float)(255 - (tok0 + e)) * lg);
#pragma unroll
            for (int m = 0; m < 4; ++m) {
                const int d = wr * 64 + m * 16 + fr;
                const f32x4* cp = csT + ((size_t)d * SEQ + u.pn * BM + tok0) / 2;
                f32x4 t[4];
#pragma unroll
                for (int i = 0; i < 4; ++i) t[i] = cp[i];
                float o1[8], o2[8];
#pragma unroll
                for (int n = 0; n < 2; ++n)
#pragma unroll
                    for (int j = 0; j < 4; ++j) { const int e = n * 4 + j; const float co = t[e >> 1][(e & 1) * 2], si = t[e >> 1][(e & 1) * 2 + 1];
                        const float x1 = acc[0][bj][m][n][j], x2 = acc[1][bj][m][n][j];
                        o1[e] = (x1 * co - x2 * si) * zs[e]; o2[e] = (x2 * co + x1 * si) * zs[e]; }
                bf16_t* rowp = O + u.coff + (size_t)d * 256 + tok0;
                u32x4 w; w.x = cvt_pk_bf16(o1[0], o1[1]); w.y = cvt_pk_bf16(o1[2], o1[3]); w.z = cvt_pk_bf16(o1[4], o1[5]); w.w = cvt_pk_bf16(o1[6], o1[7]);
                *(u32x4*)rowp = w;
                w.x = cvt_pk_bf16(o2[0], o2[1]); w.y = cvt_pk_bf16(o2[2], o2[3]); w.z = cvt_pk_bf16(o2[4], o2[5]); w.w = cvt_pk_bf16(o2[6], o2[7]);
                *(u32x4*)(rowp + (size_t)HALF * 256) = w;
            }
        }
    }
};
struct EpiP {
    static constexpr bool PERM = true;
    bf16_t* O; const float* l2g;
    __device__ __forceinline__ void operator()(const Acc& acc, const Unit& u, int wr, int wc, int fr, int fq) const {
        asm volatile("" : "+v"(fr), "+v"(fq));
        const float lg = l2g[u.pm >> 6];
#pragma unroll
        for (int bj = 0; bj < 2; ++bj) {
            const int j0 = bj * HALF + wc * 32 + 8 * fq;
            float f[8];
#pragma unroll
            for (int e = 0; e < 8; ++e) f[e] = exp2f(-(float)(j0 + e + 1) * lg);
#pragma unroll
            for (int ai = 0; ai < 2; ++ai)
#pragma unroll
                for (int m = 0; m < 4; ++m) {
                    const int i = ai * HALF + wr * 64 + m * 16 + fr;
                    float o[8];
#pragma unroll
                    for (int n = 0; n < 2; ++n)
#pragma unroll
                        for (int j = 0; j < 4; ++j) { const int e = n * 4 + j; o[e] = (i >= j0 + e) ? acc[ai][bj][m][n][j] * f[e] : 0.f; }
                    u32x4 w; w.x = cvt_pk_bf16(o[0], o[1]); w.y = cvt_pk_bf16(o[2], o[3]); w.z = cvt_pk_bf16(o[4], o[5]); w.w = cvt_pk_bf16(o[6], o[7]);
                    *(u32x4*)(O + u.coff + (size_t)i * 512 + j0) = w;
                }
        }
    }
};
struct EpiO {
    static constexpr bool PERM = true;
    bf16_t* O; f32x2* stats;
    __device__ __forceinline__ void operator()(const Acc& acc, const Unit& u, int wr, int wc, int fr, int fq) const {
        asm volatile("" : "+v"(fr), "+v"(fq));
        const int h = u.pm >> 6, nchunk = u.pm & 63, et = u.pn;
#pragma unroll
        for (int ai = 0; ai < 2; ++ai)
#pragma unroll
            for (int m = 0; m < 4; ++m) {
                const int row_in = ai * HALF + wr * 64 + m * 16 + fr;
                float s1 = 0.f, s2 = 0.f;
#pragma unroll
                for (int bj = 0; bj < 2; ++bj) {
                    const f32x4 v0 = acc[ai][bj][m][0], v1 = acc[ai][bj][m][1];
#pragma unroll
                    for (int j = 0; j < 4; ++j) { s1 += v0[j] + v1[j]; s2 += v0[j] * v0[j] + v1[j] * v1[j]; }
                    u32x4 w; w.x = cvt_pk_bf16(v0[0], v0[1]); w.y = cvt_pk_bf16(v0[2], v0[3]); w.z = cvt_pk_bf16(v1[0], v1[1]); w.w = cvt_pk_bf16(v1[2], v1[3]);
                    *(u32x4*)(O + u.coff + (size_t)row_in * RV + bj * HALF + wc * 32 + 8 * fq) = w;
                }
                s1 += __shfl_xor(s1, 16); s1 += __shfl_xor(s1, 32); s2 += __shfl_xor(s2, 16); s2 += __shfl_xor(s2, 32);
                if (fq == 0) stats[((size_t)(nchunk * 256 + row_in) * 8 + h) * 8 + et * 4 + wc] = (f32x2){s1, s2};
            }
    }
};
struct EpiGate {
    static constexpr bool PERM = true;
    bf16_t* U; const bf16_t* O; const f32x2* stats;
    __device__ __forceinline__ void operator()(const Acc& acc, const Unit& u, int wr, int wc, int fr, int fq) const {
        asm volatile("" : "+v"(fr), "+v"(fq));
        const int h = u.pn >> 1;
#pragma unroll
        for (int ai = 0; ai < 2; ++ai)
#pragma unroll
            for (int m = 0; m < 4; ++m) {
                const int row_in = ai * HALF + wr * 64 + m * 16 + fr, s = u.pm * BM + row_in;
                const f32x4* st = (const f32x4*)(stats + ((size_t)s * 8 + h) * 8);
                const size_t off = (size_t)s * RV + u.pn * BM + wc * 32 + 8 * fq;
                const f32x4 t0 = st[0], t1 = st[1], t2 = st[2], t3 = st[3];
                const u32x4 o0 = *(const u32x4*)(O + off), o1 = *(const u32x4*)(O + off + HALF);
                const float s1 = (t0[0] + t0[2]) + (t1[0] + t1[2]) + (t2[0] + t2[2]) + (t3[0] + t3[2]), s2 = (t0[1] + t0[3]) + (t1[1] + t1[3]) + (t2[1] + t2[3]) + (t3[1] + t3[3]);
                const float mu = s1 * (1.0f / 512.0f), var = fmaxf(s2 * (1.0f / 512.0f) - mu * mu, 0.f), rstd = rsqrtf(var + EPS);
#pragma unroll
                for (int bj = 0; bj < 2; ++bj) { const u32x4 ov = bj == 0 ? o0 : o1; const unsigned ow[4] = {ov.x, ov.y, ov.z, ov.w}; unsigned r[4];
#pragma unroll
                    for (int p = 0; p < 4; ++p) { const f32x4 v = acc[ai][bj][m][p >> 1]; const float g0 = silu_f(v[(p & 1) * 2]), g1 = silu_f(v[(p & 1) * 2 + 1]);
                        r[p] = cvt_pk_bf16(g0 * ((bf_lo(ow[p]) - mu) * rstd), g1 * ((bf_hi(ow[p]) - mu) * rstd)); }
                    *(u32x4*)(U + off + bj * HALF) = (u32x4){r[0], r[1], r[2], r[3]}; }
            }
    }
};
struct EpiAttQK {
    static constexpr bool PERM = false;
    bf16_t* O; const f32x4* csa;   int ld, lL;
    __device__ __forceinline__ void operator()(const Acc& acc, const Unit& u, int wr, int wc, int fr, int fq) const {
        asm volatile("" : "+v"(fr), "+v"(fq));
#pragma unroll
        for (int ai = 0; ai < 2; ++ai)
#pragma unroll
            for (int m = 0; m < 4; ++m) {
                const int row_in = ai * HALF + wr * 64 + m * 16 + fr, c = u.pm * BM + row_in;
                const int tok = ((c & ((1 << lL) - 1)) << ld) + (c >> lL);
                f32x4 t0 = (f32x4){1.f, 0.f, 1.f, 0.f}, t1 = t0;
                if (wc == 0) { const f32x4* cp = csa + ((size_t)tok * 16 + 4 * fq) / 2; t0 = cp[0]; t1 = cp[1]; }
                bf16_t* rowp = O + u.coff + (size_t)row_in * D + wc * 32 + ((fq & 1) ? 16 + 4 * (fq - 1) : 4 * fq);
#pragma unroll
                for (int bj = 0; bj < 2; ++bj) {
                    const f32x4 x1 = acc[ai][bj][m][0], x2 = acc[ai][bj][m][1];
                    float o1[4], o2[4];
                    const float cc[4] = {t0[0], t0[2], t1[0], t1[2]}, ss[4] = {t0[1], t0[3], t1[1], t1[3]};
#pragma unroll
                    for (int j = 0; j < 4; ++j) { o1[j] = x1[j] * cc[j] - x2[j] * ss[j]; o2[j] = x2[j] * cc[j] + x1[j] * ss[j]; }
                    const unsigned lo0 = cvt_pk_bf16(o1[0], o1[1]), lo1 = cvt_pk_bf16(o1[2], o1[3]), hi0 = cvt_pk_bf16(o2[0], o2[1]), hi1 = cvt_pk_bf16(o2[2], o2[3]);
                    const auto s0 = __builtin_amdgcn_permlane16_swap(lo0, hi0, false, false), s1 = __builtin_amdgcn_permlane16_swap(lo1, hi1, false, false);
                    *(u32x4*)(rowp + bj * HALF) = (u32x4){s0[0], s1[0], s0[1], s1[1]};
                }
            }
    }
};
}

struct Ctx { int tid, lane, wave, G, vcu, gw, ngw; LAS unsigned char* lds; };

__device__ __forceinline__ void transpose_items(const Ctx& X, const float* W, int K, int N, bf16_t* Wt, int& base_item) {
    const int nk = K / 64, nn = N / 64, nitems = nk * nn;
    LAS unsigned* scr = (LAS unsigned*)(X.lds + X.wave * 8448);
    int first = (X.gw - base_item % X.ngw + X.ngw) % X.ngw;
    const int kk = X.lane >> 4, n4 = (X.lane & 15) * 4;
    f32x4 ra[8], rb[8];
    if (first < nitems) { const int kt = first % nk, ntile = first / nk; const float* src = W + (size_t)(kt * 64 + 2 * kk) * N + ntile * 64 + n4;
#pragma unroll
        for (int i = 0; i < 8; ++i) { ra[i] = *(const f32x4*)(src + (size_t)(8 * i) * N); rb[i] = *(const f32x4*)(src + (size_t)(8 * i + 1) * N); } }
#pragma unroll 1
    for (int it = first; it < nitems; it += X.ngw) {
        const int kt = it % nk, ntile = it / nk;
#pragma unroll
        for (int i = 0; i < 8; ++i)
#pragma unroll
            for (int j = 0; j < 4; ++j) scr[(n4 + j) * 33 + kk + 4 * i] = cvt_pk_bf16(ra[i][j], rb[i][j]);
        if (it + X.ngw < nitems) { const int it2 = it + X.ngw, kt2 = it2 % nk, nt2 = it2 / nk; const float* src = W + (size_t)(kt2 * 64 + 2 * kk) * N + nt2 * 64 + n4;
#pragma unroll
            for (int i = 0; i < 8; ++i) { ra[i] = *(const f32x4*)(src + (size_t)(8 * i) * N); rb[i] = *(const f32x4*)(src + (size_t)(8 * i + 1) * N); } }
        __builtin_amdgcn_wave_barrier();
        asm volatile("s_waitcnt lgkmcnt(0)" ::: "memory");
#pragma unroll
        for (int r0 = 0; r0 < 64; r0 += 8) { const int r = r0 + (X.lane >> 3), seg = X.lane & 7;
            u32x4 w; w.x = scr[r * 33 + seg * 4 + 0]; w.y = scr[r * 33 + seg * 4 + 1]; w.z = scr[r * 33 + seg * 4 + 2]; w.w = scr[r * 33 + seg * 4 + 3];
            *(u32x4*)(Wt + (size_t)(ntile * 64 + r) * K + kt * 64 + seg * 8) = w; }
        asm volatile("s_waitcnt lgkmcnt(0)" ::: "memory");
        __builtin_amdgcn_wave_barrier();
    }
    base_item += nitems;
}

__device__ __forceinline__ void sincos_d(float angf, float& co, float& si) {
    const double a = (double)angf;
    const double n = rint(a * 0.63661977236758134308);
    double r = fma(-n, 1.57079632679489655800, a); r = fma(-n, 6.12323399573676603587e-17, r);
    const double r2 = r * r;
    double sp = -1.0 / 6227020800.0; sp = fma(sp, r2, 1.0 / 39916800.0); sp = fma(sp, r2, -1.0 / 362880.0); sp = fma(sp, r2, 1.0 / 5040.0); sp = fma(sp, r2, -1.0 / 120.0); sp = fma(sp, r2, 1.0 / 6.0);
    sp = fma(-sp * r2, r, r);
    double cp = 1.0 / 479001600.0; cp = fma(cp, r2, -1.0 / 3628800.0); cp = fma(cp, r2, 1.0 / 40320.0); cp = fma(cp, r2, -1.0 / 720.0); cp = fma(cp, r2, 1.0 / 24.0); cp = fma(cp, r2, -0.5); cp = fma(cp, r2, 1.0);
    const int q = ((int)(long long)n) & 3;
    const double s_ = (q & 1) ? cp : sp, c_ = (q & 1) ? sp : cp;
    si = (float)((q & 2) ? -s_ : s_); co = (float)(((q + 1) & 2) ? -c_ : c_);
}

__device__ __forceinline__ void tables_phase(const Ctx& X, const Args& a) {
    LAS float* tab = (LAS float*)(X.lds + 131072);
    f32x2* csr = (f32x2*)(a.ws + WS_CSR); f32x2* csa = (f32x2*)(a.ws + WS_CSA);
    const int gt = blockIdx.x * NT + X.tid, ngt = X.G * NT;
    for (int i = gt; i < NB * SEQ * 128; i += ngt) { const int d = i & 127, bs = i >> 7;
        const float ang = (float)a.pos[bs] * tab[d]; float co, si; sincos_d(ang, co, si);
        csr[i] = (f32x2){co, si}; }
    for (int i = gt; i < NB * SEQ * 16; i += ngt) { const int d = i & 15, bs = i >> 4;
        const float ang = (float)a.pos[bs] * tab[128 + d]; float co, si; sincos_d(ang, co, si); csa[i] = (f32x2){co, si}; }
}

__device__ __forceinline__ void modp_phase(const Ctx& X, const Args& a) {
    float* modp = (float*)(a.ws + WS_MODP);
    LAS float* red = (LAS float*)X.lds;
    const int nq = X.tid & 127, ks = X.tid >> 7;
    for (int it = blockIdx.x; it < 2 * 24 * 16; it += X.G) {
        const int layer = it / 384, r = it % 384, nch = r / 16, sl = r % 16;
        const int k0 = sl * 128 + ks * 32, n0 = nch * 512 + nq * 4;
        const float* wp = a.ada_w + ((size_t)layer * D + k0) * 12288 + n0;
        f32x4 acc0 = (f32x4){0.f, 0.f, 0.f, 0.f}, acc1 = acc0;
#pragma unroll 8
        for (int k = 0; k < 32; ++k) { const f32x4 w = *(const f32x4*)(wp + (size_t)k * 12288);
            const float c0 = silu_f(a.c[k0 + k]), c1 = silu_f(a.c[D + k0 + k]); acc0 += w * c0; acc1 += w * c1; }
        __syncthreads();
        *(LAS f32x4*)(red + (ks * 2 + 0) * 512 + nq * 4) = acc0; *(LAS f32x4*)(red + (ks * 2 + 1) * 512 + nq * 4) = acc1;
        __syncthreads();
        for (int o = X.tid; o < 1024; o += NT) { const int b = o >> 9, col = o & 511;
            const float v = red[(0 * 2 + b) * 512 + col] + red[(1 * 2 + b) * 512 + col] + red[(2 * 2 + b) * 512 + col] + red[(3 * 2 + b) * 512 + col];
            modp[(((size_t)sl * 2 + layer) * 2 + b) * 12288 + nch * 512 + col] = v; }
    }
    __syncthreads();
}
__device__ __forceinline__ void modfin_phase(const Ctx& X, const Args& a) {
    const float* modp = (const float*)(a.ws + WS_MODP); float* mod = (float*)(a.ws + WS_MOD);
    for (int i = blockIdx.x * NT + X.tid; i < 4 * 12288; i += X.G * NT) { const int layer = i / (2 * 12288), n = i % 12288;
        float v = a.ada_b[layer * 12288 + n];
#pragma unroll
        for (int s = 0; s < 16; ++s) v += modp[(size_t)s * 4 * 12288 + i];
        mod[i] = v; }
}

__device__ __forceinline__ void norm_mod_phase(const Ctx& X, const float* xin, const float* gain, const float* mod_layer, int which_shift, bf16_t* h, int r0, int r1) {
    for (int row0 = r0 + X.gw; row0 < r1; row0 += 2 * X.ngw) {
        f32x4 v[2][8]; float ss[2] = {0.f, 0.f};
#pragma unroll
        for (int r = 0; r < 2; ++r) { const int row = row0 + r * X.ngw; if (row < r1) { const float* xp = xin + (size_t)row * D;
#pragma unroll
            for (int j = 0; j < 4; ++j) { v[r][2 * j] = *(const f32x4*)(xp + 8 * (X.lane + 64 * j)); v[r][2 * j + 1] = *(const f32x4*)(xp + 8 * (X.lane + 64 * j) + 4); } } }
#pragma unroll
        for (int r = 0; r < 2; ++r) { const int row = row0 + r * X.ngw; if (row < r1) {
#pragma unroll
            for (int j = 0; j < 8; ++j) ss[r] += v[r][j][0] * v[r][j][0] + v[r][j][1] * v[r][j][1] + v[r][j][2] * v[r][j][2] + v[r][j][3] * v[r][j][3];
            ss[r] = wave_sum(ss[r]); const float rstd = rsqrtf(ss[r] * (1.0f / D) + EPS);
            const int b = row / SEQ; const float* sh = mod_layer + (size_t)b * 12288 + which_shift * D; const float* sc = sh + D;
#pragma unroll
            for (int j = 0; j < 4; ++j) { const int col = 8 * (X.lane + 64 * j); float o[8];
#pragma unroll
                for (int e = 0; e < 8; ++e) { const float y = v[r][2 * j + (e >> 2)][e & 3] * rstd * gain[col + e]; o[e] = y * (1.0f + sc[col + e]) + sh[col + e]; }
                u32x4 w; w.x = cvt_pk_bf16(o[0], o[1]); w.y = cvt_pk_bf16(o[2], o[3]); w.z = cvt_pk_bf16(o[4], o[5]); w.w = cvt_pk_bf16(o[6], o[7]);
                *(u32x4*)(h + (size_t)row * D + col) = w; } } }
    }
}
__device__ __forceinline__ void final_norm_phase(const Ctx& X, float* xio, const bf16_t* y, const float* gain) {
    for (int row0 = X.gw; row0 < T; row0 += 2 * X.ngw) {
        f32x4 v[2][8];
#pragma unroll
        for (int r = 0; r < 2; ++r) { const int row = row0 + r * X.ngw; if (row < T) { const float* xp = xio + (size_t)row * D; const bf16_t* yp = y + (size_t)row * D;
#pragma unroll
            for (int j = 0; j < 4; ++j) { const int col = 8 * (X.lane + 64 * j); const u32x4 yy = *(const u32x4*)(yp + col);
                v[r][2 * j] = *(const f32x4*)(xp + col) + (f32x4){bf_lo(yy.x), bf_hi(yy.x), bf_lo(yy.y), bf_hi(yy.y)};
                v[r][2 * j + 1] = *(const f32x4*)(xp + col + 4) + (f32x4){bf_lo(yy.z), bf_hi(yy.z), bf_lo(yy.w), bf_hi(yy.w)}; } } }
#pragma unroll
        for (int r = 0; r < 2; ++r) { const int row = row0 + r * X.ngw; if (row < T) { float* xp = xio + (size_t)row * D; float ss = 0.f;
#pragma unroll
            for (int j = 0; j < 8; ++j) ss += v[r][j][0] * v[r][j][0] + v[r][j][1] * v[r][j][1] + v[r][j][2] * v[r][j][2] + v[r][j][3] * v[r][j][3];
            ss = wave_sum(ss); const float rstd = rsqrtf(ss * (1.0f / D) + EPS);
#pragma unroll
            for (int j = 0; j < 4; ++j) { const int col = 8 * (X.lane + 64 * j); const f32x4 g0 = *(const f32x4*)(gain + col), g1 = *(const f32x4*)(gain + col + 4);
                *(f32x4*)(xp + col) = v[r][2 * j] * rstd * g0; *(f32x4*)(xp + col + 4) = v[r][2 * j + 1] * rstd * g1; } } }
    }
}

__device__ __forceinline__ void scan_phase(const Ctx& X, bf16_t* BP, const float* l2g) {
    const int gt = blockIdx.x * NT + X.tid;
    for (int i = gt; i < 8 * 512 * 32; i += X.G * NT) {
        const int dg = i & 31, e = (i >> 5) & 511, h = i >> 14;
        const float cd = exp2f(256.0f * l2g[h]);
        bf16_t* p = BP + ((size_t)h * 64 * 512 + e) * 512 + dg * 8;
        float carry[8];
#pragma unroll
        for (int j = 0; j < 8; ++j) carry[j] = 0.f;
#pragma unroll 8
        for (int n = 0; n < 64; ++n) { bf16_t* q = p + (size_t)n * 512 * 512; const u32x4 uu = *(const u32x4*)q;
            u32x4 w; w.x = cvt_pk_bf16(carry[0], carry[1]); w.y = cvt_pk_bf16(carry[2], carry[3]); w.z = cvt_pk_bf16(carry[4], carry[5]); w.w = cvt_pk_bf16(carry[6], carry[7]);
            *(u32x4*)q = w;
            carry[0] = carry[0] * cd + bf_lo(uu.x); carry[1] = carry[1] * cd + bf_hi(uu.x); carry[2] = carry[2] * cd + bf_lo(uu.y); carry[3] = carry[3] * cd + bf_hi(uu.y);
            carry[4] = carry[4] * cd + bf_lo(uu.z); carry[5] = carry[5] * cd + bf_hi(uu.z); carry[6] = carry[6] * cd + bf_lo(uu.w); carry[7] = carry[7] * cd + bf_hi(uu.w); }
    }
}

__device__ __forceinline__ void normgate_phase(const Ctx& X, const bf16_t* O, bf16_t* GG, const f32x2* stats) {
    const int col = X.tid * 8, h = X.tid >> 6;
    for (int s0 = blockIdx.x * 4; s0 < SEQ; s0 += X.G * 4) {
        u32x4 ov[4], gv[4]; f32x4 stv[4][4];
#pragma unroll
        for (int r = 0; r < 4; ++r) { const int s = s0 + r; ov[r] = *(const u32x4*)(O + (size_t)s * RV + col); gv[r] = *(const u32x4*)(GG + (size_t)s * RV + col);
            const f32x4* st = (const f32x4*)(stats + ((size_t)s * 8 + h) * 8);
#pragma unroll
            for (int j = 0; j < 4; ++j) stv[r][j] = st[j]; }
#pragma unroll
        for (int r = 0; r < 4; ++r) { const int s = s0 + r; float s1 = 0.f, s2 = 0.f;
#pragma unroll
            for (int j = 0; j < 4; ++j) { s1 += stv[r][j][0] + stv[r][j][2]; s2 += stv[r][j][1] + stv[r][j][3]; }
            const float mu = s1 * (1.0f / 512.0f), var = fmaxf(s2 * (1.0f / 512.0f) - mu * mu, 0.f), rstd = rsqrtf(var + EPS);
            const unsigned ow[4] = {ov[r].x, ov[r].y, ov[r].z, ov[r].w}, gw[4] = {gv[r].x, gv[r].y, gv[r].z, gv[r].w}; unsigned rr[4];
#pragma unroll
            for (int j = 0; j < 4; ++j) { const float a0 = bf_lo(gw[j]) * ((bf_lo(ow[j]) - mu) * rstd), a1 = bf_hi(gw[j]) * ((bf_hi(ow[j]) - mu) * rstd); rr[j] = cvt_pk_bf16(a0, a1); }
            *(u32x4*)(GG + (size_t)s * RV + col) = (u32x4){rr[0], rr[1], rr[2], rr[3]}; }
    }
}

constexpr int KP = 272, VP = 528, LDS_V = 256 * KP;
__device__ __forceinline__ void attn_load_block(const bf16_t* ACT, int g, int hh, int bl, int cbq, int tid, u32x4 (&kreg)[4], u32x4 (&vreg)[4], bf16x8 (&qf)[4], bool want_q) {
    const bf16_t* Kg = ACT + (size_t)(g * 3 + 1) * SEQ * D; const bf16_t* VTg = ACT + (size_t)(g * 3 + 2) * SEQ * D;
    if (want_q) { const int lane = tid & 63, w = tid >> 6, n = lane & 15, q = lane >> 4; const bf16_t* qrow = ACT + (size_t)(g * 3) * SEQ * D + (size_t)(cbq * 128 + 16 * w + n) * D + hh * 128;
#pragma unroll
      for (int ks = 0; ks < 4; ++ks) qf[ks] = *(const bf16x8*)(qrow + 32 * ks + 8 * q); }
    const int row = tid >> 4, seg = tid & 15;
#pragma unroll
    for (int it = 0; it < 4; ++it) kreg[it] = *(const u32x4*)(Kg + (size_t)(bl * 128 + row + 32 * it) * D + hh * 128 + seg * 8);
#pragma unroll
    for (int it = 0; it < 4; ++it) vreg[it] = *(const u32x4*)(VTg + (size_t)(hh * 128 + row + 32 * it) * SEQ + bl * 128 + seg * 8);
}
__device__ __forceinline__ void attn_phase(const Ctx& X, bf16_t* ACT, float* LSE, bf16_t* Hb, const int g_lo, const int g_hi, const bool fuse) {
    const int tid = X.tid, lane = X.lane, w = X.wave, n = lane & 15, q = lane >> 4;
    const int nruns = (g_hi - g_lo) * 16 * 16;
    u32x4 kreg[4], vreg[4]; bf16x8 qn[4];
    const int lrow = tid >> 4, lseg = tid & 15;
#pragma unroll 1
    for (int run = X.vcu; run < nruns; run += X.G) {
        const int g = g_lo + (run >> 8), hh = (run >> 4) & 15, cb0 = (run & 15) * 8; const int nb = 128 >> (2 * g);
        attn_load_block(ACT, g, hh, cb0 > 0 ? cb0 - 1 : 0, 0, tid, kreg, vreg, qn, false);
#pragma unroll 1
        for (int step = 0; step < 9; ++step) {
            const int bl = cb0 - 1 + step, slot = bl & 1;
#pragma unroll
            for (int it = 0; it < 4; ++it) *(LAS u32x4*)(X.lds + (slot * 128 + lrow + 32 * it) * KP + lseg * 16) = kreg[it];
#pragma unroll
            for (int it = 0; it < 4; ++it) *(LAS u32x4*)(X.lds + LDS_V + (lrow + 32 * it) * VP + slot * 256 + lseg * 16) = vreg[it];
            __syncthreads();
            bf16x8 qf[4];
#pragma unroll
            for (int ks = 0; ks < 4; ++ks) qf[ks] = qn[ks];
            if (step < 8) attn_load_block(ACT, g, hh, cb0 + step, cb0 + step, tid, kreg, vreg, qn, true);
            if (step >= 1) {
                const int cb = cb0 + step - 1; const bool hp = (cb & (nb - 1)) != 0; const int par = (cb + 1) & 1;
                bf16_t* qrow = ACT + (size_t)(g * 3) * SEQ * D + (size_t)(cb * 128 + 16 * w + n) * D + hh * 128;
                f32x4 sacc[10];
                const int i = 16 * w + n;
#pragma unroll
                for (int kb = 0; kb < 9; ++kb) {
                    const int j0 = 16 * w + 16 * kb; const int r0 = ((((j0 >> 7) ^ par) & 1) << 7) + (j0 & 127);
                    f32x4 sv = (f32x4){0.f, 0.f, 0.f, 0.f};
#pragma unroll
                    for (int ks = 0; ks < 4; ++ks) { const bf16x8 kf = *(const LAS bf16x8*)(X.lds + (r0 + n) * KP + (32 * ks + 8 * q) * 2); sv = __builtin_amdgcn_mfma_f32_16x16x32_bf16(kf, qf[ks], sv, 0, 0, 0); }
                    const bool blk_ok = hp || (j0 >= 128);
#pragma unroll
                    for (int jj = 0; jj < 4; ++jj) { bool valid = blk_ok;
                        if (kb == 0) valid = valid && (4 * q + jj >= n);
                        if (kb == 8) valid = valid && (4 * q + jj <= n);
                        sv[jj] = valid ? sv[jj] : -INFINITY; }
                    sacc[kb] = sv;
                }
                float mx = -INFINITY;
#pragma unroll
                for (int kb = 0; kb < 9; ++kb)
#pragma unroll
                    for (int jj = 0; jj < 4; ++jj) mx = fmaxf(mx, sacc[kb][jj]);
                mx = fmaxf(mx, __shfl_xor(mx, 16)); mx = fmaxf(mx, __shfl_xor(mx, 32));
                const float sc2 = 0.08838834764831845f * 1.4426950408889634f; float l = 0.f;
#pragma unroll
                for (int kb = 0; kb < 9; ++kb)
#pragma unroll
                    for (int jj = 0; jj < 4; ++jj) { const float p = __builtin_amdgcn_exp2f((sacc[kb][jj] - mx) * sc2); sacc[kb][jj] = p; l += p; }
                sacc[9] = (f32x4){0.f, 0.f, 0.f, 0.f};
                l += __shfl_xor(l, 16); l += __shfl_xor(l, 32);
                f32x4 oacc[8];
#pragma unroll
                for (int eb = 0; eb < 8; ++eb) oacc[eb] = (f32x4){0.f, 0.f, 0.f, 0.f};
#pragma unroll
                for (int s2 = 0; s2 < 5; ++s2) {
                    const int ja = 16 * w + 32 * s2, jb = ja + 16; const int jac = ja > 240 ? 240 : ja, jbc = jb > 240 ? 240 : jb;
                    const int ca = ((((jac >> 7) ^ par) & 1) << 7) + (jac & 127), cbb = ((((jbc >> 7) ^ par) & 1) << 7) + (jbc & 127);
                    u32x4 pw; pw.x = cvt_pk_bf16(sacc[2 * s2][0], sacc[2 * s2][1]); pw.y = cvt_pk_bf16(sacc[2 * s2][2], sacc[2 * s2][3]);
                    pw.z = cvt_pk_bf16(sacc[2 * s2 + 1][0], sacc[2 * s2 + 1][1]); pw.w = cvt_pk_bf16(sacc[2 * s2 + 1][2], sacc[2 * s2 + 1][3]);
                    const bf16x8 pf = __builtin_bit_cast(bf16x8, pw);
#pragma unroll
                    for (int eb = 0; eb < 8; ++eb) { const int e = 16 * eb + n;
                        const u32x2 va = *(const LAS u32x2*)(X.lds + LDS_V + e * VP + (ca + 4 * q) * 2), vb = *(const LAS u32x2*)(X.lds + LDS_V + e * VP + (cbb + 4 * q) * 2);
                        const u32x4 vv = (u32x4){va.x, va.y, vb.x, vb.y};
                        oacc[eb] = __builtin_amdgcn_mfma_f32_16x16x32_bf16(__builtin_bit_cast(bf16x8, vv), pf, oacc[eb], 0, 0, 0); }
                }
                const float il = 1.0f / l; const float lse_own = mx * 0.08838834764831845f + __logf(l);
                const int ecol = (q & 1) ? 16 + 4 * (q - 1) : 4 * q;
                if (!fuse) {
#pragma unroll
                    for (int eb = 0; eb < 8; eb += 2) {
                        const unsigned a0 = cvt_pk_bf16(oacc[eb][0] * il, oacc[eb][1] * il), a1 = cvt_pk_bf16(oacc[eb][2] * il, oacc[eb][3] * il);
                        const unsigned b0 = cvt_pk_bf16(oacc[eb + 1][0] * il, oacc[eb + 1][1] * il), b1 = cvt_pk_bf16(oacc[eb + 1][2] * il, oacc[eb + 1][3] * il);
                        const auto s0 = __builtin_amdgcn_permlane16_swap(a0, b0, false, false), s1 = __builtin_amdgcn_permlane16_swap(a1, b1, false, false);
                        *(u32x4*)(qrow + 16 * eb + ecol) = (u32x4){s0[0], s1[0], s0[1], s1[1]}; }
                    if (q == 0) LSE[((size_t)g * SEQ + cb * 128 + i) * 16 + hh] = lse_own;
                } else {
                    const int c2 = cb * 128 + i, t = ((c2 & 1023) << 4) + (c2 >> 10), c1 = ((t & 3) << 12) + (t >> 2);
                    const float l0 = LSE[((size_t)0 * SEQ + t) * 16 + hh], l1 = LSE[((size_t)1 * SEQ + c1) * 16 + hh];
                    const bf16_t* o0 = ACT + (size_t)t * D + hh * 128 + ecol; const bf16_t* o1 = ACT + (size_t)3 * SEQ * D + (size_t)c1 * D + hh * 128 + ecol;
                    u32x4 a0[4], a1[4];
#pragma unroll
                    for (int ep = 0; ep < 4; ++ep) { a0[ep] = *(const u32x4*)(o0 + 32 * ep); a1[ep] = *(const u32x4*)(o1 + 32 * ep); }
                    const float mm = fmaxf(lse_own, fmaxf(l0, l1)); const float e0 = __expf(l0 - mm), e1 = __expf(l1 - mm), e2 = __expf(lse_own - mm);
                    const float iw = 1.0f / (e0 + e1 + e2); const float w0 = e0 * iw, w1 = e1 * iw, w2 = e2 * iw * il;
                    bf16_t* orow = Hb + (size_t)t * D + hh * 128 + ecol;
#pragma unroll
                    for (int ep = 0; ep < 4; ++ep) { const int eb = 2 * ep;
                        const auto p0x = __builtin_amdgcn_permlane16_swap(a0[ep].x, a0[ep].z, false, false), p0y = __builtin_amdgcn_permlane16_swap(a0[ep].y, a0[ep].w, false, false);
                        const auto p1x = __builtin_amdgcn_permlane16_swap(a1[ep].x, a1[ep].z, false, false), p1y = __builtin_amdgcn_permlane16_swap(a1[ep].y, a1[ep].w, false, false);
                        const unsigned r0 = cvt_pk_bf16(w0 * bf_lo(p0x[0]) + w1 * bf_lo(p1x[0]) + w2 * oacc[eb][0], w0 * bf_hi(p0x[0]) + w1 * bf_hi(p1x[0]) + w2 * oacc[eb][1]);
                        const unsigned r1 = cvt_pk_bf16(w0 * bf_lo(p0y[0]) + w1 * bf_lo(p1y[0]) + w2 * oacc[eb][2], w0 * bf_hi(p0y[0]) + w1 * bf_hi(p1y[0]) + w2 * oacc[eb][3]);
                        const unsigned r2 = cvt_pk_bf16(w0 * bf_lo(p0x[1]) + w1 * bf_lo(p1x[1]) + w2 * oacc[eb + 1][0], w0 * bf_hi(p0x[1]) + w1 * bf_hi(p1x[1]) + w2 * oacc[eb + 1][1]);
                        const unsigned r3 = cvt_pk_bf16(w0 * bf_lo(p0y[1]) + w1 * bf_lo(p1y[1]) + w2 * oacc[eb + 1][2], w0 * bf_hi(p0y[1]) + w1 * bf_hi(p1y[1]) + w2 * oacc[eb + 1][3]);
                        const auto s0 = __builtin_amdgcn_permlane16_swap(r0, r2, false, false), s1 = __builtin_amdgcn_permlane16_swap(r1, r3, false, false);
                        *(u32x4*)(orow + 32 * ep) = (u32x4){s0[0], s1[0], s0[1], s1[1]}; }
                }
            }
            __syncthreads();
        }
    }
}
__device__ __forceinline__ void combine_phase(const Ctx& X, const bf16_t* ACT, const float* LSE, bf16_t* Hb) {
    const int col = X.tid * 4, hh = X.tid >> 5;
    for (int s0 = blockIdx.x * 8; s0 < SEQ; s0 += X.G * 8) {
        float ls[8][3]; u32x2 ov[8][3];
#pragma unroll
        for (int r = 0; r < 8; ++r) { const int s = s0 + r;
#pragma unroll
            for (int g = 0; g < 3; ++g) { const int ld = 2 * g, lL = 14 - ld; const int c = ((s & ((1 << ld) - 1)) << lL) + (s >> ld);
                ls[r][g] = LSE[((size_t)g * SEQ + c) * 16 + hh]; ov[r][g] = *(const u32x2*)(ACT + (size_t)(g * 3) * SEQ * D + (size_t)c * D + col); } }
#pragma unroll
        for (int r = 0; r < 8; ++r) { const int s = s0 + r;
            const float mx = fmaxf(ls[r][0], fmaxf(ls[r][1], ls[r][2])); float wg[3], wsum = 0.f;
#pragma unroll
            for (int g = 0; g < 3; ++g) { wg[g] = __expf(ls[r][g] - mx); wsum += wg[g]; }
            const float iw = 1.0f / wsum; float o[4] = {0.f, 0.f, 0.f, 0.f};
#pragma unroll
            for (int g = 0; g < 3; ++g) { const float ww = wg[g] * iw; o[0] += ww * bf_lo(ov[r][g].x); o[1] += ww * bf_hi(ov[r][g].x); o[2] += ww * bf_lo(ov[r][g].y); o[3] += ww * bf_hi(ov[r][g].y); }
            u32x2 rr; rr.x = cvt_pk_bf16(o[0], o[1]); rr.y = cvt_pk_bf16(o[2], o[3]); *(u32x2*)(Hb + (size_t)s * D + col) = rr; }
    }
}

__global__ void __launch_bounds__(NT, 2) fwd_megakernel(Args a) {
    extern __shared__ __attribute__((aligned(16))) unsigned char lds_raw[];
    cg::grid_group grid = cg::this_grid();
    Ctx X; X.G = gridDim.x; X.ngw = X.G * 8; X.lds = (LAS unsigned char*)lds_raw;
#define REFRESH() do { int t_ = threadIdx.x; asm volatile("" : "+v"(t_)); int bx_ = blockIdx.x; asm volatile("" : "+s"(bx_)); X.tid = t_; X.lane = t_ & 63; X.wave = __builtin_amdgcn_readfirstlane(t_ >> 6); \
        X.vcu = (X.G % 8 == 0) ? (bx_ % 8) * (X.G / 8) + bx_ / 8 : bx_; X.gw = bx_ * 8 + X.wave; } while (0)
    REFRESH();
    unsigned char* ws = a.ws;
    bf16_t* Wt = (bf16_t*)(ws + WS_W); bf16_t* H = (bf16_t*)(ws + WS_H); bf16_t* ACT = (bf16_t*)(ws + WS_ACT);
    float* MOD = (float*)(ws + WS_MOD); float* L2G = (float*)(ws + WS_L2G); f32x2* STATS = (f32x2*)(ws + WS_STATS); float* LSE = (float*)(ws + WS_LSE);
    using namespace pg8;
#define SYNC() xcd_barrier(xbar)

    { volatile LAS unsigned* st = (volatile LAS unsigned*)(X.lds + LDS_MISC); if (X.tid < 4) st[X.tid] = 0u; __syncthreads(); }
    XcdBarrier xbar = xcd_barrier_post((unsigned*)(ws + WS_BAR), (volatile LAS unsigned*)(X.lds + LDS_MISC));
    { LAS float* tab = (LAS float*)(X.lds + 131072);
      if (X.tid < 144) tab[X.tid] = X.tid < 128 ? a.invf_ret[X.tid] : a.invf_att[X.tid - 128];
      if (blockIdx.x == 0 && X.tid < 8) L2G[X.tid] = a.l2g[X.tid];
      __syncthreads(); }

    tables_phase(X, a);
    modp_phase(X, a);
    grid.sync();
    modfin_phase(X, a);

#pragma unroll 1
    for (int layer = 0; layer < 2; ++layer) {
        REFRESH();
        const float* MODL = MOD + (size_t)layer * 2 * 12288;
        { int base = 0;
          if (layer == 0) { transpose_items(X, a.ret_w_in, D, RPROJ, Wt + W0_RIN, base); transpose_items(X, a.ret_w_out, RV, D, Wt + W0_ROUT, base); }
          else            { transpose_items(X, a.att_w_in, D, APROJ, Wt + W1_AIN, base); transpose_items(X, a.att_w_out, D, D, Wt + W1_AOUT, base); }
          const size_t w1o = layer == 0 ? W0_1 : W1_1, w2o = layer == 0 ? W0_2 : W1_2;
          transpose_items(X, a.mlp_w1 + (size_t)layer * D * DFF, D, DFF, Wt + w1o, base);
          transpose_items(X, a.mlp_w2 + (size_t)layer * D * DFF, DFF, D, Wt + w2o, base); }
        SYNC();
        const float* xin = layer == 0 ? a.x : a.out;
        if (layer == 0) {
#pragma unroll 1
            for (int b = 0; b < NB; ++b) {
                REFRESH();
                bf16_t* Hb = H + (size_t)b * SEQ * D;
                if (b == 0) { norm_mod_phase(X, xin, a.norm_mix, MODL, 0, H, 0, T); SYNC(); }
                const f32x4* csr = (const f32x4*)(ws + WS_CSR + (size_t)b * SEQ * 128 * 8); const f32x4* csrt = (const f32x4*)(ws + WS_CSRT + (size_t)b * SEQ * 128 * 8);
#pragma unroll 1
                for (int qk = 0; qk < 2; ++qk) {
                    Gemm g{Hb, Wt + W0_RIN + (size_t)qk * 2048 * D, D, D, D}; auto S = mk_sched(64, 8, MapRetQK{qk == 0 ? 131072u : 65536u});
                    EpiRetQK E{ACT + (qk == 0 ? A_AP : A_KT), qk == 0 ? 512 : 256, csr, qk, L2G, ACT + A_KZ};
                    gemm_phase(X.lds, g, S, E); }
                {
                    Gemm g{Wt + W0_RIN + (size_t)4096 * D, Hb, D, D, D}; auto S = mk_sched(16, 64, MapVT0{});
                    EpiBf16<0> E{ACT + A_BP, 512}; gemm_phase(X.lds, g, S, E); }
                SYNC();
                {
                    Gemm g{ACT + A_AP, ACT + A_KT, 512, 256, 256}; auto S = mk_sched(512, 1, MapP{});
                    EpiP E{ACT + A_AP, L2G};
                    gemm_phase(X.lds, g, S, E); }
                {
                    Gemm g{ACT + A_BP, ACT + A_KZ, 512, 256, 256}; auto S = mk_sched(1024, 1, MapU{});
                    EpiBf16<0> E{ACT + A_BP, 512}; gemm_phase(X.lds, g, S, E); }
                SYNC();
                scan_phase(X, ACT + A_BP, L2G);
                SYNC();
                {
                    Gemm g{ACT + A_AP, ACT + A_BP, 512, 512, 512}; auto S = mk_sched(512, 2, MapO{});
                    EpiO E{ACT + A_O, STATS}; gemm_phase(X.lds, g, S, E); }
                SYNC();
                {
                    Gemm g{Hb, Wt + W0_RIN + (size_t)8192 * D, D, D, D}; auto S = mk_sched(64, 16, MapG{});
                    EpiGate E{ACT + A_GG, ACT + A_O, STATS}; gemm_phase(X.lds, g, S, E); }
                SYNC();
                {
                    Gemm g{ACT + A_GG, Wt + W0_ROUT, RV, RV, RV}; auto S = mk_sched(64, 8, MapOut0{});
                    EpiRes E{a.x + (size_t)b * SEQ * D, a.out + (size_t)b * SEQ * D, MODL + (size_t)b * 12288 + 2 * D, 0}; gemm_phase(X.lds, g, S, E); }
                if (b == NB - 1) SYNC();
            }
        } else {
#pragma unroll 1
            for (int b = 0; b < NB; ++b) {
                REFRESH();
                bf16_t* Hb = H + (size_t)b * SEQ * D;
                if (b == 0) { norm_mod_phase(X, xin, a.norm_mix + D, MODL, 0, H, 0, T); SYNC(); }
                const f32x4* csa = (const f32x4*)(ws + WS_CSA + (size_t)b * SEQ * 16 * 8);
#pragma unroll 1
                for (int gq = 0; gq < 6; ++gq) {
                    const int gi = gq >> 1, qk = gq & 1, ld = 2 * gi, lL = 14 - ld, dil = 1 << ld;
                    Gemm g{Hb, Wt + W1_AIN + (size_t)(gi * 6144 + qk * 2048) * D, dil * D, D, D}; auto S = mk_sched(64, 8, MapAttQK{6 - ld, ld});
                    EpiAttQK E{ACT + (size_t)(gi * 3 + qk) * SEQ * D, csa, ld, lL}; gemm_phase(X.lds, g, S, E); }
#pragma unroll 1
                for (int gi = 0; gi < 3; ++gi) {
                    const int ld = 2 * gi, dil = 1 << ld;
                    Gemm g{Wt + W1_AIN + (size_t)(gi * 6144 + 4096) * D, Hb, D, dil * D, D}; auto S = mk_sched(8, 64, MapAttVT{6 - ld, ld});
                    EpiBf16<0> E{ACT + (size_t)(gi * 3 + 2) * SEQ * D, SEQ}; gemm_phase(X.lds, g, S, E); }
                SYNC();
#pragma unroll 1
                for (int ap = 0; ap < 2; ++ap) {
                    REFRESH();
                    attn_phase(X, ACT, LSE, Hb, ap == 0 ? 0 : 2, ap == 0 ? 2 : 3, ap == 1);
                    SYNC(); }
            }
            { Gemm g{H, Wt + W1_AOUT, D, D, D}; auto S = mk_sched(128, 8, MapOut1{});
              EpiRes E{a.out, a.out, MODL + 2 * D, 12288}; gemm_phase(X.lds, g, S, E); }
            SYNC();
        }
        norm_mod_phase(X, a.out, a.norm_mlp + layer * D, MODL, 3, H, 0, T);
        SYNC();
        { Gemm g{H, Wt + (layer == 0 ? W0_1 : W1_1), D, D, D}; auto S = mk_sched(128, 32, MapMlp1{});
          EpiBf16<2> E{ACT, DFF}; gemm_phase(X.lds, g, S, E);
#ifdef PROBE_A
          SYNC(); gemm_phase(X.lds, g, S, E);
#endif
        }
        SYNC();
        { Gemm g{ACT, Wt + (layer == 0 ? W0_2 : W1_2), DFF, DFF, DFF}; auto S = mk_sched(128, 8, MapMlp2{});
          if (layer == 0) { EpiRes E{a.out, a.out, MODL + 5 * D, 12288}; gemm_phase(X.lds, g, S, E); }
          else { EpiY E{H, MODL + 5 * D, 12288}; gemm_phase(X.lds, g, S, E); } }
        SYNC();
    }
    final_norm_phase(X, a.out, H, a.final_norm);
}

extern "C" void kernel_launch(void* const* d_in, const int* in_sizes, int n_in, void* d_out, int out_size, void* d_ws, size_t ws_size, hipStream_t stream) {
    static int grid = 0;
    if (grid == 0) {
        if (n_in != 14 || out_size != T * D || ws_size < WS_END) { fprintf(stderr, "kernel_launch: unexpected shapes (n_in %d out %d ws %zu need %zu)\n", n_in, out_size, ws_size, (size_t)WS_END); grid = -1; return; }
        int dev = 0, cus = 0, per_cu = 0;
        hipGetDevice(&dev); hipDeviceGetAttribute(&cus, hipDeviceAttributeMultiprocessorCount, dev);
        if (hipFuncSetAttribute((const void*)fwd_megakernel, hipFuncAttributeMaxDynamicSharedMemorySize, LDS_BYTES) != hipSuccess) { fprintf(stderr, "kernel_launch: hipFuncSetAttribute failed\n"); grid = -1; return; }
        hipOccupancyMaxActiveBlocksPerMultiprocessor(&per_cu, (const void*)fwd_megakernel, NT, LDS_BYTES);
        if (per_cu < 1) { fprintf(stderr, "kernel_launch: occupancy query says %d blocks/CU\n", per_cu); per_cu = 1; }
        grid = cus;
    }
    if (grid < 0) return;
    Args a{};
    a.x = (const float*)d_in[0]; a.c = (const float*)d_in[1]; a.pos = (const int*)d_in[2]; a.ada_w = (const float*)d_in[3]; a.ada_b = (const float*)d_in[4];
    a.norm_mix = (const float*)d_in[5]; a.norm_mlp = (const float*)d_in[6]; a.ret_w_in = (const float*)d_in[7]; a.ret_w_out = (const float*)d_in[8];
    a.att_w_in = (const float*)d_in[9]; a.att_w_out = (const float*)d_in[10]; a.mlp_w1 = (const float*)d_in[11]; a.mlp_w2 = (const float*)d_in[12]; a.final_norm = (const float*)d_in[13];
    a.out = (float*)d_out; a.ws = (unsigned char*)d_ws;
    for (int d = 0; d < 128; ++d) a.invf_ret[d] = (float)pow(10000.0, -(double)d / 128.0);
    for (int d = 0; d < 16; ++d) a.invf_att[d] = (float)pow(500000.0, -(double)d / 16.0);
    for (int h = 0; h < 8; ++h) a.l2g[h] = (float)log2(1.0 - exp2(-5.0 - (double)h));
    if (hipMemsetAsync((char*)d_ws + WS_BAR, 0, BAR_BYTES, stream) != hipSuccess) { fprintf(stderr, "kernel_launch: memset failed\n"); return; }
    void* args[] = {&a};
    hipError_t e = hipLaunchCooperativeKernel((const void*)fwd_megakernel, dim3(grid), dim3(NT), args, LDS_BYTES, stream);
    if (e != hipSuccess) fprintf(stderr, "cooperative launch failed: %s (grid %d)\n", hipGetErrorString(e), grid);
}
```

```cpp
#include <hip/hip_runtime.h>
#include <hip/hip_cooperative_groups.h>
#include <cstdio>
#include <cmath>
namespace cg = cooperative_groups;

#define LAS __attribute__((address_space(3)))
typedef unsigned short bf16_t;
typedef short bf16x8 __attribute__((ext_vector_type(8)));
typedef float f32x4 __attribute__((ext_vector_type(4)));
typedef float f32x2 __attribute__((ext_vector_type(2)));
typedef unsigned u32x4 __attribute__((ext_vector_type(4)));
typedef unsigned u32x2 __attribute__((ext_vector_type(2)));

constexpr int D = 2048, SEQ = 16384, NB = 2, T = NB * SEQ, DFF = 8192;
constexpr int RPROJ = 12288, APROJ = 18432, RV = 4096;
constexpr float EPS = 1e-6f;
constexpr int NT = 512;
constexpr int LDS_MISC = 137216;
constexpr int LDS_BYTES = LDS_MISC + 256;

constexpr size_t WS_W      = 0;
constexpr size_t W_BYTES   = 150994944;
constexpr size_t WS_CSR    = WS_W + W_BYTES;
constexpr size_t WS_CSRT   = WS_CSR + (size_t)2 * SEQ * 128 * 8;
constexpr size_t WS_CSA    = WS_CSRT + (size_t)2 * SEQ * 128 * 8;
constexpr size_t WS_MODP   = WS_CSA + (size_t)2 * SEQ * 16 * 8;
constexpr size_t WS_MOD    = WS_MODP + (size_t)16 * 4 * 12288 * 4;
constexpr size_t WS_STATS  = WS_MOD + (size_t)4 * 12288 * 4;
constexpr size_t WS_LSE    = WS_STATS + (size_t)SEQ * 128 * 4;
constexpr size_t WS_L2G    = WS_LSE + (size_t)3 * SEQ * 16 * 4;
constexpr size_t WS_BAR    = WS_L2G + 256;
constexpr size_t BAR_BYTES = 16384;
constexpr size_t WS_H      = WS_BAR + BAR_BYTES;
constexpr size_t WS_ACT    = WS_H + (size_t)T * D * 2;
constexpr size_t ACT_BYTES = 671088640;
constexpr size_t WS_END    = WS_ACT + ACT_BYTES;
constexpr size_t A_AP = 0;
constexpr size_t A_BP = A_AP + (size_t)512 * 256 * 512;
constexpr size_t A_KT = A_BP + (size_t)512 * 512 * 512;
constexpr size_t A_KZ = A_KT + (size_t)512 * 65536;
constexpr size_t A_O  = A_KT;
constexpr size_t A_GG = A_KZ + (size_t)512 * 65536;
constexpr size_t W0_RIN = 0, W0_ROUT = W0_RIN + (size_t)RPROJ * D, W0_1 = W0_ROUT + (size_t)D * RV, W0_2 = W0_1 + (size_t)DFF * D;
constexpr size_t W1_AIN = 0, W1_AOUT = W1_AIN + (size_t)APROJ * D, W1_1 = W1_AOUT + (size_t)D * D, W1_2 = W1_1 + (size_t)DFF * D;

struct Args {
    const float* x; const float* c; const int* pos; const float* ada_w; const float* ada_b; const float* norm_mix; const float* norm_mlp;
    const float* ret_w_in; const float* ret_w_out; const float* att_w_in; const float* att_w_out; const float* mlp_w1; const float* mlp_w2; const float* final_norm;
    float* out; unsigned char* ws;
    float invf_ret[128]; float invf_att[16]; float l2g[8];
};

__device__ __forceinline__ unsigned cvt_pk_bf16(float lo, float hi) { unsigned r; asm volatile("v_cvt_pk_bf16_f32 %0, %1, %2" : "=v"(r) : "v"(lo), "v"(hi)); return r; }
__device__ __forceinline__ float bf_lo(unsigned w) { return __uint_as_float(w << 16); }
__device__ __forceinline__ float bf_hi(unsigned w) { return __uint_as_float(w & 0xffff0000u); }
__device__ __forceinline__ float wave_sum(float v) {
#pragma unroll
    for (int o = 32; o >= 1; o >>= 1) v += __shfl_xor(v, o);
    return v;
}
__device__ __forceinline__ float silu_f(float v) { return v / (1.0f + __expf(-v)); }


#define XB_TMO      128
#define XB_XCNT(j)  (256  + 64 * (j))
#define XB_XSUB(j)  (1280 + 64 * (j))
#define XB_XGEN(j)  (2304 + 64 * (j))
#define XB_TOP      3328
#define XB_TOPGEN   3392
#define XCD_BAR_WORDS 3456
#define XB_SPIN_CAP (1u << 18)
__device__ __forceinline__ unsigned xb_ld(unsigned* p)              { return __hip_atomic_load(p, __ATOMIC_RELAXED, __HIP_MEMORY_SCOPE_AGENT); }
__device__ __forceinline__ unsigned xb_add(unsigned* p, unsigned v) { return __hip_atomic_fetch_add(p, v, __ATOMIC_RELAXED, __HIP_MEMORY_SCOPE_AGENT); }
__device__ __forceinline__ unsigned xb_xcc_id() { return (unsigned)__builtin_amdgcn_s_getreg((3 << 11) | 20) & 0xFu; }
#define XB_SPIN(cond, bar) do { unsigned _sp = 0; while (cond) { __builtin_amdgcn_s_sleep(1); \
    if ((++_sp & 255u) == 0u) { if (xb_ld(&(bar)[XB_TMO])) break; if (_sp > XB_SPIN_CAP) { atomicAdd(&(bar)[XB_TMO], 1u); break; } } } } while (0)
struct XcdBarrier { unsigned* bar; unsigned x; volatile LAS unsigned* st; };
__device__ __forceinline__ XcdBarrier xcd_barrier_post(unsigned* bar, volatile LAS unsigned* st) {
    XcdBarrier b; b.bar = bar; b.x = xb_xcc_id(); b.st = st;
    if (threadIdx.x == 0) (void)xb_add(&bar[XB_XCNT(b.x)], 1u);
    return b;
}
__device__ __forceinline__ void xcd_barrier_complete(unsigned* bar, unsigned x, unsigned& nloc, unsigned& nx) {
    const unsigned G = gridDim.x * gridDim.y * gridDim.z;
    unsigned sum, cnt, mine, sp = 0u;
    for (;;) {
        sum = 0u; cnt = 0u; mine = 0u;
#pragma unroll
        for (unsigned j = 0; j < 16; ++j) { const unsigned c = xb_ld(&bar[XB_XCNT(j)]); sum += c; cnt += (c > 0u) ? 1u : 0u; mine = (j == x) ? c : mine; }
        if (sum == G) break;
        __builtin_amdgcn_s_sleep(1);
        if ((++sp & 255u) == 0u) { if (xb_ld(&bar[XB_TMO])) break; if (sp > XB_SPIN_CAP) { atomicAdd(&bar[XB_TMO], 1u); break; } }
    }
    nloc = mine > 0u ? mine : 1u; nx = cnt > 0u ? cnt : 1u;
}
__device__ __forceinline__ void xcd_barrier(const XcdBarrier& b) {
    asm volatile("s_waitcnt vmcnt(0)" ::: "memory");
    __syncthreads();
    if (threadIdx.x == 0) {
        unsigned* bar = b.bar;
        __builtin_amdgcn_s_waitcnt(0);
        unsigned nloc = b.st[0], nx = b.st[1];
        if (nloc == 0u) { xcd_barrier_complete(bar, b.x, nloc, nx); b.st[0] = nloc; b.st[1] = nx; }
        const unsigned old = xb_add(&bar[XB_XSUB(b.x)], 1u);
        const unsigned gen = old / nloc;
        if (old + 1u == (gen + 1u) * nloc) {
            __builtin_amdgcn_fence(__ATOMIC_RELEASE, "agent");
            asm volatile("s_waitcnt vmcnt(0)" ::: "memory");
            const unsigned og = xb_add(&bar[XB_TOP], 1u);
            const unsigned tg = og / nx;
            if (og + 1u == (tg + 1u) * nx) xb_add(&bar[XB_TOPGEN], 1u);
            else XB_SPIN(xb_ld(&bar[XB_TOPGEN]) == tg, bar);
            __builtin_amdgcn_fence(__ATOMIC_ACQUIRE, "agent");
            xb_add(&bar[XB_XGEN(b.x)], 1u);
            asm volatile("s_waitcnt vmcnt(0)" ::: "memory");
        } else {
            XB_SPIN(xb_ld(&bar[XB_XGEN(b.x)]) == gen, bar);
            __builtin_amdgcn_fence(__ATOMIC_ACQUIRE, "agent");
            asm volatile("s_waitcnt vmcnt(0)" ::: "memory");
        }
    }
    __syncthreads();
}

namespace pg8 {
constexpr int BM = 256, BK = 64, HALF = 128, HTB = HALF * BK * 2, STAGE_BYTES = 8 * HTB, NXCD = 8, WGM = 8;
__device__ __forceinline__ int lds_byte(int r, int c) { const int st = (r >> 4) * 2 + (c >> 5), rr = r & 15, cc = c & 31, ob = rr * 64 + cc * 2; return st * 1024 + (ob ^ (((ob >> 9) & 1) << 5)); }
__device__ __forceinline__ void stage_rc(int b, int& R, int& C) { const int st = b / 1024, sb = b % 1024, swz = sb ^ (((sb >> 9) & 1) << 5); R = (st >> 1) * 16 + swz / 64; C = (st & 1) * 32 + (swz % 64) / 2; }
__device__ __forceinline__ int perm32(int rho) { const int n = rho >> 4, i = rho & 15; return 8 * (i >> 2) + 4 * n + (i & 3); }

struct Unit { unsigned aoff, boff, coff; int pm, pn; };
struct Gemm { const bf16_t* A; const bf16_t* Bt; int lda, ldb, K; };

template <class Map> struct Sched {
    int nM, nN, nwg, G, c; Map map;
    __device__ __forceinline__ bool next(int i, Unit& u) const {
        const long L = (long)i * G + c; if (L >= nwg) return false;
        int wgid = (int)L; { const int q = nwg / NXCD, r = nwg % NXCD, xcd = wgid % NXCD, off = wgid / NXCD; wgid = (xcd < r ? xcd * (q + 1) : r * (q + 1) + (xcd - r) * q) + off; }
        const int nig = WGM * nN, gid = wgid / nig, fm = gid * WGM, gsz = (nM - fm) < WGM ? (nM - fm) : WGM;
        u.pm = fm + ((wgid % nig) % gsz); u.pn = (wgid % nig) / gsz;
        map(u.pm, u.pn, u);
        return true;
    }
};
template <class Map> __device__ __forceinline__ Sched<Map> mk_sched(int nM, int nN, Map m) { Sched<Map> s; s.nM = nM; s.nN = nN; s.nwg = nM * nN; s.G = gridDim.x; s.c = blockIdx.x; s.map = m; return s; }
constexpr unsigned MB1 = 1048576u;
struct MapRetQK { unsigned tile; __device__ __forceinline__ void operator()(int pm, int pn, Unit& u) const { u.aoff = pm * MB1; u.boff = pn * MB1; u.coff = (unsigned)(pn * 64 + pm) * tile; } };
struct MapKzT { __device__ __forceinline__ void operator()(int pm, int pn, Unit& u) const { u.aoff = pm * MB1; u.boff = pn * MB1; u.coff = (unsigned)(pm * 64 + pn) * 65536u; } };
struct MapVT0 { __device__ __forceinline__ void operator()(int pm, int pn, Unit& u) const { u.aoff = pm * MB1; u.boff = pn * MB1; u.coff = 256u + (unsigned)((pm >> 1) * 64 + pn) * 262144u + (unsigned)(pm & 1) * 131072u; } };
struct MapG { __device__ __forceinline__ void operator()(int pm, int pn, Unit& u) const { u.aoff = pm * MB1; u.boff = pn * MB1; u.coff = (unsigned)pm * (256u * 4096u) + pn * 256u; } };
struct MapP { __device__ __forceinline__ void operator()(int pm, int pn, Unit& u) const { u.aoff = pm * 262144u; u.boff = pm * 131072u; u.coff = 256u + pm * 131072u; } };
struct MapU { __device__ __forceinline__ void operator()(int pm, int pn, Unit& u) const { u.aoff = 512u + pm * 262144u; u.boff = (unsigned)(pm >> 1) * 131072u; u.coff = pm * 131072u; } };
struct MapO { __device__ __forceinline__ void operator()(int pm, int pn, Unit& u) const { u.aoff = pm * 262144u; u.boff = pm * 524288u + pn * 262144u; u.coff = (unsigned)(pm >> 6) * 512u + (unsigned)(pm & 63) * (256u * 4096u) + pn * 256u; } };
struct MapOut0 { __device__ __forceinline__ void operator()(int pm, int pn, Unit& u) const { u.aoff = pm * (2u * MB1); u.boff = pn * (2u * MB1); u.coff = 0; } };
struct MapMlp1 { __device__ __forceinline__ void operator()(int pm, int pn, Unit& u) const { u.aoff = pm * MB1; u.boff = pn * MB1; u.coff = (unsigned)pm * (256u * 8192u) + pn * 256u; } };
struct MapMlp2 { __device__ __forceinline__ void operator()(int pm, int pn, Unit& u) const { u.aoff = pm * (4u * MB1); u.boff = pn * (4u * MB1); u.coff = 0; } };
struct MapAttQK { int sh, ld; __device__ __forceinline__ void operator()(int pm, int pn, Unit& u) const { u.aoff = (unsigned)(pm >> sh) * 4096u + ((unsigned)(pm & ((1 << sh) - 1)) * MB1 << ld); u.boff = pn * MB1; u.coff = (unsigned)pm * (256u * 2048u) + pn * 256u; } };
struct MapAttVT { int sh, ld; __device__ __forceinline__ void operator()(int pm, int pn, Unit& u) const { u.aoff = pm * MB1; u.boff = (unsigned)(pn >> sh) * 4096u + ((unsigned)(pn & ((1 << sh) - 1)) * MB1 << ld); u.coff = (unsigned)pm * (256u * 16384u) + pn * 256u; } };
struct MapOut1 { __device__ __forceinline__ void operator()(int pm, int pn, Unit& u) const { u.aoff = pm * MB1; u.boff = pn * MB1; u.coff = 0; } };

template <class Epi, class Map>
__device__ __forceinline__ void gemm_phase(LAS unsigned char* lds, const Gemm g, const Sched<Map>& S, const Epi& E) {
    int tid_ = threadIdx.x; asm volatile("" : "+v"(tid_));
    const int tid = tid_, wid = __builtin_amdgcn_readfirstlane(tid >> 6), lane = tid & 63, wr = wid >> 2, wc = wid & 3, fr = lane & 15, fq = lane >> 4;
    const int K = g.K, nt = K / BK;
    unsigned voffA[2], voffB[2];
#pragma unroll
    for (int i = 0; i < 2; ++i) { int R, C; stage_rc(tid * 16 + i * 8192, R, C); const int Rb = Epi::PERM ? ((R & ~31) + perm32(R & 31)) : R;
        voffA[i] = (unsigned)(R * g.lda + C) * 2u; voffB[i] = (unsigned)(Rb * g.ldb + C) * 2u; }
    const size_t kstep = (size_t)(BK * 2);
    const size_t hstepA = (size_t)HALF * g.lda * 2, hstepB = (size_t)HALF * g.ldb * 2;
    const unsigned ldsw = (unsigned)wid * 1024u;
    const int aoff = lds_byte(wr * 64 + fr, fq * 8), boff = lds_byte(wc * 32 + fr, fq * 8);
#define PG8_SA(b, h) (((b) * 2 + (h)) * HTB)
#define PG8_SB(b, h) ((4 + (b) * 2 + (h)) * HTB)
#define PG8_STAGE(bufoff, gbase, voff) do { _Pragma("unroll") for (int _i = 0; _i < 2; ++_i) \
        __builtin_amdgcn_global_load_lds((const unsigned*)((const char*)(gbase) + (voff)[_i]), (LAS unsigned*)(lds + (bufoff) + ldsw + _i * 8192), 16, 0, 0); } while (0)
#define PG8_LDA(dst, b, h) do { _Pragma("unroll") for (int m = 0; m < 4; ++m) _Pragma("unroll") for (int k = 0; k < 2; ++k) dst[m][k] = *(const LAS bf16x8*)(lds + PG8_SA(b, h) + aoff + m * 2048 + k * 1024); } while (0)
#define PG8_LDB(dst, b, h) do { _Pragma("unroll") for (int n = 0; n < 2; ++n) _Pragma("unroll") for (int k = 0; k < 2; ++k) dst[n][k] = *(const LAS bf16x8*)(lds + PG8_SB(b, h) + boff + n * 2048 + k * 1024); } while (0)
#define PG8_MMA(ai, bj, At, Bt) do { __builtin_amdgcn_s_setprio(1); _Pragma("unroll") for (int m = 0; m < 4; ++m) _Pragma("unroll") for (int n = 0; n < 2; ++n) _Pragma("unroll") for (int k = 0; k < 2; ++k) \
        acc[ai][bj][m][n] = __builtin_amdgcn_mfma_f32_16x16x32_bf16(Bt[n][k], At[m][k], acc[ai][bj][m][n], 0, 0, 0); __builtin_amdgcn_s_setprio(0); } while (0)
#define PG8_WAIT_V(n) asm volatile("s_waitcnt vmcnt(" #n ")" ::: "memory")
#define PG8_WAIT_L(n) asm volatile("s_waitcnt lgkmcnt(" #n ")" ::: "memory")
#define PG8_BAR __builtin_amdgcn_s_barrier()
#define PG8_SCHED __builtin_amdgcn_sched_barrier(0)
    Unit cur, nxt; int ui = 0;
    if (!S.next(0, cur)) return;
    f32x4 acc[2][2][4][2];
#pragma unroll
    for (int a = 0; a < 2; ++a)
#pragma unroll
        for (int b = 0; b < 2; ++b)
#pragma unroll
            for (int m = 0; m < 4; ++m)
#pragma unroll
                for (int n = 0; n < 2; ++n) acc[a][b][m][n] = (f32x4){0.f, 0.f, 0.f, 0.f};
    bf16x8 At[4][2], B0[2][2], B1[2][2];
    const char* cA = (const char*)g.A + cur.aoff; const char* cB = (const char*)g.Bt + cur.boff;
    PG8_STAGE(PG8_SB(0, 0), cB, voffB); PG8_STAGE(PG8_SB(0, 1), cB + hstepB, voffB); PG8_STAGE(PG8_SA(0, 0), cA, voffA); PG8_STAGE(PG8_SA(0, 1), cA + hstepA, voffA);
    if (wr == 1) PG8_BAR;
    PG8_WAIT_V(2); PG8_BAR;
    PG8_STAGE(PG8_SB(1, 0), cB + kstep, voffB); PG8_STAGE(PG8_SA(1, 0), cA + kstep, voffA); PG8_STAGE(PG8_SB(1, 1), cB + hstepB + kstep, voffB);
    PG8_WAIT_V(6); PG8_BAR;
#pragma unroll 1
    for (;;) {
        const bool has_next = S.next(ui + 1, nxt);
        const char* nA = has_next ? (const char*)g.A + nxt.aoff : cA; const char* nB = has_next ? (const char*)g.Bt + nxt.boff : cB;
#pragma unroll 1
        for (int t = 0; t < nt; t += 2) {
            const bool last = (t == nt - 2);
            const char* a1 = cA + (size_t)(t + 1) * kstep;
            const char* a2 = last ? nA : cA + (size_t)(t + 2) * kstep; const char* b2 = last ? nB : cB + (size_t)(t + 2) * kstep;
            const char* a3 = a2 + kstep; const char* b3 = b2 + kstep;
            PG8_LDB(B0, 0, 0); PG8_LDB(B1, 0, 1); PG8_SCHED; PG8_LDA(At, 0, 0); PG8_STAGE(PG8_SA(1, 1), a1 + hstepA, voffA);
            PG8_WAIT_V(8); PG8_WAIT_L(0); PG8_BAR; PG8_MMA(0, 0, At, B0); PG8_MMA(0, 1, At, B1); PG8_BAR; PG8_SCHED;
            PG8_LDA(At, 0, 1); PG8_STAGE(PG8_SB(0, 0), b2, voffB); PG8_STAGE(PG8_SB(0, 1), b2 + hstepB, voffB); PG8_STAGE(PG8_SA(0, 0), a2, voffA);
            PG8_WAIT_V(8); PG8_WAIT_L(0); PG8_BAR; PG8_MMA(1, 0, At, B0); PG8_MMA(1, 1, At, B1); PG8_BAR; PG8_SCHED;
            PG8_LDB(B0, 1, 0); PG8_LDB(B1, 1, 1); PG8_SCHED; PG8_LDA(At, 1, 0); PG8_STAGE(PG8_SA(0, 1), a2 + hstepA, voffA);
            PG8_WAIT_V(8); PG8_WAIT_L(0); PG8_BAR; PG8_MMA(0, 0, At, B0); PG8_MMA(0, 1, At, B1); PG8_BAR; PG8_SCHED;
            PG8_LDA(At, 1, 1); PG8_STAGE(PG8_SB(1, 0), b3, voffB); PG8_STAGE(PG8_SB(1, 1), b3 + hstepB, voffB); PG8_STAGE(PG8_SA(1, 0), a3, voffA);
            PG8_WAIT_V(8); PG8_WAIT_L(0); PG8_BAR; PG8_MMA(1, 0, At, B0); PG8_MMA(1, 1, At, B1); PG8_BAR; PG8_SCHED;
        }
        if (wr == 0) PG8_BAR;
        E(acc, cur, wr, wc, fr, fq);
        if (!has_next) break;
#pragma unroll
        for (int a = 0; a < 2; ++a)
#pragma unroll
            for (int b = 0; b < 2; ++b)
#pragma unroll
                for (int m = 0; m < 4; ++m)
#pragma unroll
                    for (int n = 0; n < 2; ++n) acc[a][b][m][n] = (f32x4){0.f, 0.f, 0.f, 0.f};
        cur = nxt; cA = nA; cB = nB; ++ui;
        if (wr == 1) PG8_BAR;
    }
    PG8_WAIT_V(0);
    PG8_BAR;
#undef PG8_SA
#undef PG8_SB
#undef PG8_STAGE
#undef PG8_LDA
#undef PG8_LDB
#undef PG8_MMA
#undef PG8_WAIT_V
#undef PG8_WAIT_L
#undef PG8_BAR
#undef PG8_SCHED
}

typedef f32x4 Acc[2][2][4][2];

template <int ACT> struct EpiBf16 {
    static constexpr bool PERM = true;
    bf16_t* O; int ldc;
    __device__ __forceinline__ void operator()(const Acc& acc, const Unit& u, int wr, int wc, int fr, int fq) const {
        asm volatile("" : "+v"(fr), "+v"(fq));
        bf16_t* base = O + u.coff + (size_t)(wr * 64 + fr) * ldc + wc * 32 + 8 * fq;
#pragma unroll
        for (int ai = 0; ai < 2; ++ai)
#pragma unroll
            for (int m = 0; m < 4; ++m) { bf16_t* rowp = base + (size_t)(ai * HALF + m * 16) * ldc;
#pragma unroll
                for (int bj = 0; bj < 2; ++bj) { f32x4 v0 = acc[ai][bj][m][0], v1 = acc[ai][bj][m][1];
                    if (ACT == 1) {
#pragma unroll
                        for (int j = 0; j < 4; ++j) { v0[j] = silu_f(v0[j]); v1[j] = silu_f(v1[j]); } }
                    if (ACT == 2) {
#pragma unroll
                        for (int j = 0; j < 4; ++j) { const float a = fmaxf(v0[j], 0.f), b = fmaxf(v1[j], 0.f); v0[j] = a * a; v1[j] = b * b; } }
                    u32x4 w; w.x = cvt_pk_bf16(v0[0], v0[1]); w.y = cvt_pk_bf16(v0[2], v0[3]); w.z = cvt_pk_bf16(v1[0], v1[1]); w.w = cvt_pk_bf16(v1[2], v1[3]);
                    *(u32x4*)(rowp + bj * HALF) = w; } }
    }
};
struct EpiRes {
    static constexpr bool PERM = false;
    const float* base; float* out; const float* gate; int gate_bstride;
    __device__ __forceinline__ void operator()(const Acc& acc, const Unit& u, int wr, int wc, int fr, int fq) const {
        asm volatile("" : "+v"(fr), "+v"(fq));
        const int row0 = u.pm * BM + wr * 64 + fr, col0 = u.pn * BM + wc * 32 + 4 * fq;
        const float* gp = gate + (size_t)(u.pm >> 6) * gate_bstride + col0;
        f32x4 gv[2][2];
#pragma unroll
        for (int bj = 0; bj < 2; ++bj)
#pragma unroll
            for (int n = 0; n < 2; ++n) gv[bj][n] = *(const f32x4*)(gp + bj * HALF + n * 16);
#pragma unroll
        for (int aim = 0; aim < 4; ++aim) { const int ai = aim >> 1, m0 = (aim & 1) * 2;
            f32x4 bs[2][2][2];
#pragma unroll
            for (int mm = 0; mm < 2; ++mm) { const size_t off = (size_t)(row0 + ai * HALF + (m0 + mm) * 16) * D + col0;
#pragma unroll
                for (int bj = 0; bj < 2; ++bj)
#pragma unroll
                    for (int n = 0; n < 2; ++n) bs[mm][bj][n] = *(const f32x4*)(base + off + bj * HALF + n * 16); }
#pragma unroll
            for (int mm = 0; mm < 2; ++mm) { const size_t off = (size_t)(row0 + ai * HALF + (m0 + mm) * 16) * D + col0;
#pragma unroll
                for (int bj = 0; bj < 2; ++bj)
#pragma unroll
                    for (int n = 0; n < 2; ++n) *(f32x4*)(out + off + bj * HALF + n * 16) = bs[mm][bj][n] + gv[bj][n] * acc[ai][bj][m0 + mm][n]; }
            asm volatile("" ::: "memory"); }
    }
};
struct EpiY {
    static constexpr bool PERM = true;
    bf16_t* Y; const float* gate; int gate_bstride;
    __device__ __forceinline__ void operator()(const Acc& acc, const Unit& u, int wr, int wc, int fr, int fq) const {
        asm volatile("" : "+v"(fr), "+v"(fq));
        const int col0 = u.pn * BM + wc * 32 + 8 * fq;
        const float* gp = gate + (size_t)(u.pm >> 6) * gate_bstride + col0;
        f32x4 gv[2][2];
#pragma unroll
        for (int bj = 0; bj < 2; ++bj) { gv[bj][0] = *(const f32x4*)(gp + bj * HALF); gv[bj][1] = *(const f32x4*)(gp + bj * HALF + 4); }
        bf16_t* base = Y + (size_t)(u.pm * BM + wr * 64 + fr) * D + col0;
#pragma unroll
        for (int ai = 0; ai < 2; ++ai)
#pragma unroll
            for (int m = 0; m < 4; ++m) { bf16_t* rowp = base + (size_t)(ai * HALF + m * 16) * D;
#pragma unroll
                for (int bj = 0; bj < 2; ++bj) { const f32x4 v0 = acc[ai][bj][m][0] * gv[bj][0], v1 = acc[ai][bj][m][1] * gv[bj][1];
                    u32x4 w; w.x = cvt_pk_bf16(v0[0], v0[1]); w.y = cvt_pk_bf16(v0[2], v0[3]); w.z = cvt_pk_bf16(v1[0], v1[1]); w.w = cvt_pk_bf16(v1[2], v1[3]);
                    *(u32x4*)(rowp + bj * HALF) = w; } }
    }
};
struct EpiRetQK {
    static constexpr bool PERM = true;
    bf16_t* O; int ldc; const f32x4* cs;   int mode;   const float* l2g; bf16_t* KZ;
    __device__ __forceinline__ void operator()(const Acc& acc, const Unit& u, int wr, int wc, int fr, int fq) const {
        asm volatile("" : "+v"(fr), "+v"(fq));
        const float lg = l2g[u.pn];
#pragma unroll
        for (int ai = 0; ai < 2; ++ai)
#pragma unroll
            for (int m = 0; m < 4; ++m) {
                const int row_in = ai * HALF + wr * 64 + m * 16 + fr, s = u.pm * BM + row_in;
                const float rs = mode == 0 ? exp2f((float)(row_in + 1) * lg) : 0.0625f;
                const f32x4* cp = cs + ((size_t)s * 128 + wc * 32 + 8 * fq) / 2;
                f32x4 t[4];
#pragma unroll
                for (int i = 0; i < 4; ++i) t[i] = cp[i];
                float o1[8], o2[8];
#pragma unroll
                for (int n = 0; n < 2; ++n)
#pragma unroll
                    for (int j = 0; j < 4; ++j) { const int e = n * 4 + j; const float co = t[e >> 1][(e & 1) * 2], si = t[e >> 1][(e & 1) * 2 + 1];
                        const float x1 = acc[ai][0][m][n][j], x2 = acc[ai][1][m][n][j];
                        o1[e] = (x1 * co - x2 * si) * rs; o2[e] = (x2 * co + x1 * si) * rs; }
                bf16_t* rowp = O + u.coff + (size_t)row_in * ldc + wc * 32 + 8 * fq;
                u32x4 w; w.x = cvt_pk_bf16(o1[0], o1[1]); w.y = cvt_pk_bf16(o1[2], o1[3]); w.z = cvt_pk_bf16(o1[4], o1[5]); w.w = cvt_pk_bf16(o1[6], o1[7]);
                *(u32x4*)rowp = w;
                w.x = cvt_pk_bf16(o2[0], o2[1]); w.y = cvt_pk_bf16(o2[2], o2[3]); w.z = cvt_pk_bf16(o2[4], o2[5]); w.w = cvt_pk_bf16(o2[6], o2[7]);
                *(u32x4*)(rowp + HALF) = w;
                if (mode == 1) {
                    const float z = exp2f((float)(255 - row_in) * lg);
                    bf16_t* kz = KZ + u.coff + (size_t)(wc * 32 + 8 * fq) * 256 + row_in;
#pragma unroll
                    for (int e = 0; e < 8; e += 2) { const unsigned p1 = cvt_pk_bf16(o1[e] * z, o1[e + 1] * z), p2 = cvt_pk_bf16(o2[e] * z, o2[e + 1] * z);
                        kz[(size_t)e * 256] = (bf16_t)(p1 & 0xffffu); kz[(size_t)(e + 1) * 256] = (bf16_t)(p1 >> 16);
                        kz[(size_t)(e + HALF) * 256] = (bf16_t)(p2 & 0xffffu); kz[(size_t)(e + 1 + HALF) * 256] = (bf16_t)(p2 >> 16); }
                }
            }
    }
};
struct EpiKzT {
    static constexpr bool PERM = true;
    bf16_t* O; const f32x4* csT;   const float* l2g;
    __device__ __forceinline__ void operator()(const Acc& acc, const Unit& u, int wr, int wc, int fr, int fq) const {
        asm volatile("" : "+v"(fr), "+v"(fq));
        const float lg = l2g[u.pm];
#pragma unroll
        for (int bj = 0; bj < 2; ++bj) {
            const int tok0 = bj * HALF + wc * 32 + 8 * fq;
            float zs[8];
#pragma unroll
            for (int e = 0; e < 8; ++e) zs[e] = 0.0625f * exp2f((float)(255 - (tok0 + e)) * lg);
#pragma unroll
            for (int m = 0; m < 4; ++m) {
                const int d = wr * 64 + m * 16 + fr;
                const f32x4* cp = csT + ((size_t)d * SEQ + u.pn * BM + tok0) / 2;
                f32x4 t[4];
#pragma unroll
                for (int i = 0; i < 4; ++i) t[i] = cp[i];
                float o1[8], o2[8];
#pragma unroll
                for (int n = 0; n < 2; ++n)
#pragma unroll
                    for (int j = 0; j < 4; ++j) { const int e = n * 4 + j; const float co = t[e >> 1][(e & 1) * 2], si = t[e >> 1][(e & 1) * 2 + 1];
                        const float x1 = acc[0][bj][m][n][j], x2 = acc[1][bj][m][n][j];
                        o1[e] = (x1 * co - x2 * si) * zs[e]; o2[e] = (x2 * co + x1 * si) * zs[e]; }
                bf16_t* rowp = O + u.coff + (size_t)d * 256 + tok0;
                u32x4 w; w.x = cvt_pk_bf16(o1[0], o1[1]); w.y = cvt_pk_bf16(o1[2], o1[3]); w.z = cvt_pk_bf16(o1[4], o1[5]); w.w = cvt_pk_bf16(o1[6], o1[7]);
                *(u32x4*)rowp = w;
                w.x = cvt_pk_bf16(o2[0], o2[1]); w.y = cvt_pk_bf16(o2[2], o2[3]); w.z = cvt_pk_bf16(o2[4], o2[5]); w.w = cvt_pk_bf16(o2[6], o2[7]);
                *(u32x4*)(rowp + (size_t)HALF * 256) = w;
            }
        }
    }
};
struct EpiP {
    static constexpr bool PERM = true;
    bf16_t* O; const float* l2g;
    __device__ __forceinline__ void operator()(const Acc& acc, const Unit& u, int wr, int wc, int fr, int fq) const {
        asm volatile("" : "+v"(fr), "+v"(fq));
        const float lg = l2g[u.pm >> 6];
#pragma unroll
        for (int bj = 0; bj < 2; ++bj) {
            const int j0 = bj * HALF + wc * 32 + 8 * fq;
            float f[8];
#pragma unroll
            for (int e = 0; e < 8; ++e) f[e] = exp2f(-(float)(j0 + e + 1) * lg);
#pragma unroll
            for (int ai = 0; ai < 2; ++ai)
#pragma unroll
                for (int m = 0; m < 4; ++m) {
                    const int i = ai * HALF + wr * 64 + m * 16 + fr;
                    float o[8];
#pragma unroll
                    for (int n = 0; n < 2; ++n)
#pragma unroll
                        for (int j = 0; j < 4; ++j) { const int e = n * 4 + j; o[e] = (i >= j0 + e) ? acc[ai][bj][m][n][j] * f[e] : 0.f; }
                    u32x4 w; w.x = cvt_pk_bf16(o[0], o[1]); w.y = cvt_pk_bf16(o[2], o[3]); w.z = cvt_pk_bf16(o[4], o[5]); w.w = cvt_pk_bf16(o[6], o[7]);
                    *(u32x4*)(O + u.coff + (size_t)i * 512 + j0) = w;
                }
        }
    }
};
struct EpiO {
    static constexpr bool PERM = true;
    bf16_t* O; f32x2* stats;
    __device__ __forceinline__ void operator()(const Acc& acc, const Unit& u, int wr, int wc, int fr, int fq) const {
        asm volatile("" : "+v"(fr), "+v"(fq));
        const int h = u.pm >> 6, nchunk = u.pm & 63, et = u.pn;
#pragma unroll
        for (int ai = 0; ai < 2; ++ai)
#pragma unroll
            for (int m = 0; m < 4; ++m) {
                const int row_in = ai * HALF + wr * 64 + m * 16 + fr;
                float s1 = 0.f, s2 = 0.f;
#pragma unroll
                for (int bj = 0; bj < 2; ++bj) {
                    const f32x4 v0 = acc[ai][bj][m][0], v1 = acc[ai][bj][m][1];
#pragma unroll
                    for (int j = 0; j < 4; ++j) { s1 += v0[j] + v1[j]; s2 += v0[j] * v0[j] + v1[j] * v1[j]; }
                    u32x4 w; w.x = cvt_pk_bf16(v0[0], v0[1]); w.y = cvt_pk_bf16(v0[2], v0[3]); w.z = cvt_pk_bf16(v1[0], v1[1]); w.w = cvt_pk_bf16(v1[2], v1[3]);
                    *(u32x4*)(O + u.coff + (size_t)row_in * RV + bj * HALF + wc * 32 + 8 * fq) = w;
                }
                s1 += __shfl_xor(s1, 16); s1 += __shfl_xor(s1, 32); s2 += __shfl_xor(s2, 16); s2 += __shfl_xor(s2, 32);
                if (fq == 0) stats[((size_t)(nchunk * 256 + row_in) * 8 + h) * 8 + et * 4 + wc] = (f32x2){s1, s2};
            }
    }
};
struct EpiGate {
    static constexpr bool PERM = true;
    bf16_t* U; const bf16_t* O; const f32x2* stats;
    __device__ __forceinline__ void operator()(const Acc& acc, const Unit& u, int wr, int wc, int fr, int fq) const {
        asm volatile("" : "+v"(fr), "+v"(fq));
        const int h = u.pn >> 1;
#pragma unroll
        for (int ai = 0; ai < 2; ++ai)
#pragma unroll
            for (int m = 0; m < 4; ++m) {
                const int row_in = ai * HALF + wr * 64 + m * 16 + fr, s = u.pm * BM + row_in;
                const f32x4 tq = ((const f32x4*)(stats + ((size_t)s * 8 + h) * 8))[fq];
                const size_t off = (size_t)s * RV + u.pn * BM + wc * 32 + 8 * fq;
                const u32x4 o0 = *(const u32x4*)(O + off), o1 = *(const u32x4*)(O + off + HALF);
                float s1 = tq[0] + tq[2], s2 = tq[1] + tq[3];
                { const auto r1 = __builtin_amdgcn_permlane16_swap(__float_as_uint(s1), __float_as_uint(s1), false, false); s1 = __uint_as_float(r1[0]) + __uint_as_float(r1[1]);
                  const auto r2 = __builtin_amdgcn_permlane16_swap(__float_as_uint(s2), __float_as_uint(s2), false, false); s2 = __uint_as_float(r2[0]) + __uint_as_float(r2[1]);
                  const auto r3 = __builtin_amdgcn_permlane32_swap(__float_as_uint(s1), __float_as_uint(s1), false, false); s1 = __uint_as_float(r3[0]) + __uint_as_float(r3[1]);
                  const auto r4 = __builtin_amdgcn_permlane32_swap(__float_as_uint(s2), __float_as_uint(s2), false, false); s2 = __uint_as_float(r4[0]) + __uint_as_float(r4[1]); }
                const float mu = s1 * (1.0f / 512.0f), var = fmaxf(s2 * (1.0f / 512.0f) - mu * mu, 0.f), rstd = rsqrtf(var + EPS);
#pragma unroll
                for (int bj = 0; bj < 2; ++bj) { const u32x4 ov = bj == 0 ? o0 : o1; const unsigned ow[4] = {ov.x, ov.y, ov.z, ov.w}; unsigned r[4];
#pragma unroll
                    for (int p = 0; p < 4; ++p) { const f32x4 v = acc[ai][bj][m][p >> 1]; const float g0 = silu_f(v[(p & 1) * 2]), g1 = silu_f(v[(p & 1) * 2 + 1]);
                        r[p] = cvt_pk_bf16(g0 * ((bf_lo(ow[p]) - mu) * rstd), g1 * ((bf_hi(ow[p]) - mu) * rstd)); }
                    *(u32x4*)(U + off + bj * HALF) = (u32x4){r[0], r[1], r[2], r[3]}; }
            }
    }
};
struct EpiAttQK {
    static constexpr bool PERM = false;
    bf16_t* O; const f32x4* csa;   int ld, lL;
    __device__ __forceinline__ void operator()(const Acc& acc, const Unit& u, int wr, int wc, int fr, int fq) const {
        asm volatile("" : "+v"(fr), "+v"(fq));
#pragma unroll
        for (int ai = 0; ai < 2; ++ai)
#pragma unroll
            for (int m = 0; m < 4; ++m) {
                const int row_in = ai * HALF + wr * 64 + m * 16 + fr, c = u.pm * BM + row_in;
                const int tok = ((c & ((1 << lL) - 1)) << ld) + (c >> lL);
                f32x4 t0 = (f32x4){1.f, 0.f, 1.f, 0.f}, t1 = t0;
                if (wc == 0) { const f32x4* cp = csa + ((size_t)tok * 16 + 4 * fq) / 2; t0 = cp[0]; t1 = cp[1]; }
                bf16_t* rowp = O + u.coff + (size_t)row_in * D + wc * 32 + ((fq & 1) ? 16 + 4 * (fq - 1) : 4 * fq);
#pragma unroll
                for (int bj = 0; bj < 2; ++bj) {
                    const f32x4 x1 = acc[ai][bj][m][0], x2 = acc[ai][bj][m][1];
                    float o1[4], o2[4];
                    const float cc[4] = {t0[0], t0[2], t1[0], t1[2]}, ss[4] = {t0[1], t0[3], t1[1], t1[3]};
#pragma unroll
                    for (int j = 0; j < 4; ++j) { o1[j] = x1[j] * cc[j] - x2[j] * ss[j]; o2[j] = x2[j] * cc[j] + x1[j] * ss[j]; }
                    const unsigned lo0 = cvt_pk_bf16(o1[0], o1[1]), lo1 = cvt_pk_bf16(o1[2], o1[3]), hi0 = cvt_pk_bf16(o2[0], o2[1]), hi1 = cvt_pk_bf16(o2[2], o2[3]);
                    const auto s0 = __builtin_amdgcn_permlane16_swap(lo0, hi0, false, false), s1 = __builtin_amdgcn_permlane16_swap(lo1, hi1, false, false);
                    *(u32x4*)(rowp + bj * HALF) = (u32x4){s0[0], s1[0], s0[1], s1[1]};
                }
            }
    }
};
}

struct Ctx { int tid, lane, wave, G, vcu, gw, ngw; LAS unsigned char* lds; };

__device__ __forceinline__ void transpose_items(const Ctx& X, const float* W, int K, int N, bf16_t* Wt, int& base_item) {
    const int nk = K / 64, nn = N / 64, nitems = nk * nn;
    LAS unsigned* scr = (LAS unsigned*)(X.lds + X.wave * 8448);
    int first = (X.gw - base_item % X.ngw + X.ngw) % X.ngw;
    const int kk = X.lane >> 4, n4 = (X.lane & 15) * 4;
    f32x4 ra[8], rb[8];
    if (first < nitems) { const int kt = first % nk, ntile = first / nk; const float* src = W + (size_t)(kt * 64 + 2 * kk) * N + ntile * 64 + n4;
#pragma unroll
        for (int i = 0; i < 8; ++i) { ra[i] = *(const f32x4*)(src + (size_t)(8 * i) * N); rb[i] = *(const f32x4*)(src + (size_t)(8 * i + 1) * N); } }
#pragma unroll 1
    for (int it = first; it < nitems; it += X.ngw) {
        const int kt = it % nk, ntile = it / nk;
#pragma unroll
        for (int i = 0; i < 8; ++i)
#pragma unroll
            for (int j = 0; j < 4; ++j) scr[(n4 + j) * 33 + kk + 4 * i] = cvt_pk_bf16(ra[i][j], rb[i][j]);
        if (it + X.ngw < nitems) { const int it2 = it + X.ngw, kt2 = it2 % nk, nt2 = it2 / nk; const float* src = W + (size_t)(kt2 * 64 + 2 * kk) * N + nt2 * 64 + n4;
#pragma unroll
            for (int i = 0; i < 8; ++i) { ra[i] = *(const f32x4*)(src + (size_t)(8 * i) * N); rb[i] = *(const f32x4*)(src + (size_t)(8 * i + 1) * N); } }
        __builtin_amdgcn_wave_barrier();
        asm volatile("s_waitcnt lgkmcnt(0)" ::: "memory");
#pragma unroll
        for (int r0 = 0; r0 < 64; r0 += 8) { const int r = r0 + (X.lane >> 3), seg = X.lane & 7;
            u32x4 w; w.x = scr[r * 33 + seg * 4 + 0]; w.y = scr[r * 33 + seg * 4 + 1]; w.z = scr[r * 33 + seg * 4 + 2]; w.w = scr[r * 33 + seg * 4 + 3];
            *(u32x4*)(Wt + (size_t)(ntile * 64 + r) * K + kt * 64 + seg * 8) = w; }
        asm volatile("s_waitcnt lgkmcnt(0)" ::: "memory");
        __builtin_amdgcn_wave_barrier();
    }
    base_item += nitems;
}

__device__ __forceinline__ void sincos_d(float angf, float& co, float& si) {
    const double a = (double)angf;
    const double n = rint(a * 0.63661977236758134308);
    double r = fma(-n, 1.57079632679489655800, a); r = fma(-n, 6.12323399573676603587e-17, r);
    const double r2 = r * r;
    double sp = -1.0 / 6227020800.0; sp = fma(sp, r2, 1.0 / 39916800.0); sp = fma(sp, r2, -1.0 / 362880.0); sp = fma(sp, r2, 1.0 / 5040.0); sp = fma(sp, r2, -1.0 / 120.0); sp = fma(sp, r2, 1.0 / 6.0);
    sp = fma(-sp * r2, r, r);
    double cp = 1.0 / 479001600.0; cp = fma(cp, r2, -1.0 / 3628800.0); cp = fma(cp, r2, 1.0 / 40320.0); cp = fma(cp, r2, -1.0 / 720.0); cp = fma(cp, r2, 1.0 / 24.0); cp = fma(cp, r2, -0.5); cp = fma(cp, r2, 1.0);
    const int q = ((int)(long long)n) & 3;
    const double s_ = (q & 1) ? cp : sp, c_ = (q & 1) ? sp : cp;
    si = (float)((q & 2) ? -s_ : s_); co = (float)(((q + 1) & 2) ? -c_ : c_);
}

__device__ __forceinline__ void tables_phase(const Ctx& X, const Args& a) {
    LAS float* tab = (LAS float*)(X.lds + 131072);
    f32x2* csr = (f32x2*)(a.ws + WS_CSR); f32x2* csa = (f32x2*)(a.ws + WS_CSA);
    const int gt = blockIdx.x * NT + X.tid, ngt = X.G * NT;
    for (int i = gt; i < NB * SEQ * 128; i += ngt) { const int d = i & 127, bs = i >> 7;
        const float ang = (float)a.pos[bs] * tab[d]; float co, si; sincos_d(ang, co, si);
        csr[i] = (f32x2){co, si}; }
    for (int i = gt; i < NB * SEQ * 16; i += ngt) { const int d = i & 15, bs = i >> 4;
        const float ang = (float)a.pos[bs] * tab[128 + d]; float co, si; sincos_d(ang, co, si); csa[i] = (f32x2){co, si}; }
}

__device__ __forceinline__ void modp_phase(const Ctx& X, const Args& a) {
    float* modp = (float*)(a.ws + WS_MODP);
    LAS float* red = (LAS float*)X.lds;
    const int nq = X.tid & 127, ks = X.tid >> 7;
    for (int it = blockIdx.x; it < 2 * 24 * 16; it += X.G) {
        const int layer = it / 384, r = it % 384, nch = r / 16, sl = r % 16;
        const int k0 = sl * 128 + ks * 32, n0 = nch * 512 + nq * 4;
        const float* wp = a.ada_w + ((size_t)layer * D + k0) * 12288 + n0;
        f32x4 acc0 = (f32x4){0.f, 0.f, 0.f, 0.f}, acc1 = acc0;
#pragma unroll 8
        for (int k = 0; k < 32; ++k) { const f32x4 w = *(const f32x4*)(wp + (size_t)k * 12288);
            const float c0 = silu_f(a.c[k0 + k]), c1 = silu_f(a.c[D + k0 + k]); acc0 += w * c0; acc1 += w * c1; }
        __syncthreads();
        *(LAS f32x4*)(red + (ks * 2 + 0) * 512 + nq * 4) = acc0; *(LAS f32x4*)(red + (ks * 2 + 1) * 512 + nq * 4) = acc1;
        __syncthreads();
        for (int o = X.tid; o < 1024; o += NT) { const int b = o >> 9, col = o & 511;
            const float v = red[(0 * 2 + b) * 512 + col] + red[(1 * 2 + b) * 512 + col] + red[(2 * 2 + b) * 512 + col] + red[(3 * 2 + b) * 512 + col];
            modp[(((size_t)sl * 2 + layer) * 2 + b) * 12288 + nch * 512 + col] = v; }
    }
    __syncthreads();
}
__device__ __forceinline__ void modfin_phase(const Ctx& X, const Args& a) {
    const float* modp = (const float*)(a.ws + WS_MODP); float* mod = (float*)(a.ws + WS_MOD);
    for (int i = blockIdx.x * NT + X.tid; i < 4 * 12288; i += X.G * NT) { const int layer = i / (2 * 12288), n = i % 12288;
        float v = a.ada_b[layer * 12288 + n];
#pragma unroll
        for (int s = 0; s < 16; ++s) v += modp[(size_t)s * 4 * 12288 + i];
        mod[i] = v; }
}

__device__ __forceinline__ void norm_mod_phase(const Ctx& X, const float* xin, const float* gain, const float* mod_layer, int which_shift, bf16_t* h, int r0, int r1) {
    for (int row0 = r0 + X.gw; row0 < r1; row0 += 2 * X.ngw) {
        f32x4 v[2][8]; float ss[2] = {0.f, 0.f};
#pragma unroll
        for (int r = 0; r < 2; ++r) { const int row = row0 + r * X.ngw; if (row < r1) { const float* xp = xin + (size_t)row * D;
#pragma unroll
            for (int j = 0; j < 4; ++j) { v[r][2 * j] = *(const f32x4*)(xp + 8 * (X.lane + 64 * j)); v[r][2 * j + 1] = *(const f32x4*)(xp + 8 * (X.lane + 64 * j) + 4); } } }
#pragma unroll
        for (int r = 0; r < 2; ++r) { const int row = row0 + r * X.ngw; if (row < r1) {
#pragma unroll
            for (int j = 0; j < 8; ++j) ss[r] += v[r][j][0] * v[r][j][0] + v[r][j][1] * v[r][j][1] + v[r][j][2] * v[r][j][2] + v[r][j][3] * v[r][j][3];
            ss[r] = wave_sum(ss[r]); const float rstd = rsqrtf(ss[r] * (1.0f / D) + EPS);
            const int b = row / SEQ; const float* sh = mod_layer + (size_t)b * 12288 + which_shift * D; const float* sc = sh + D;
#pragma unroll
            for (int j = 0; j < 4; ++j) { const int col = 8 * (X.lane + 64 * j); float o[8];
#pragma unroll
                for (int e = 0; e < 8; ++e) { const float y = v[r][2 * j + (e >> 2)][e & 3] * rstd * gain[col + e]; o[e] = y * (1.0f + sc[col + e]) + sh[col + e]; }
                u32x4 w; w.x = cvt_pk_bf16(o[0], o[1]); w.y = cvt_pk_bf16(o[2], o[3]); w.z = cvt_pk_bf16(o[4], o[5]); w.w = cvt_pk_bf16(o[6], o[7]);
                *(u32x4*)(h + (size_t)row * D + col) = w; } } }
    }
}
__device__ __forceinline__ void final_norm_phase(const Ctx& X, float* xio, const bf16_t* y, const float* gain) {
    for (int row0 = X.gw; row0 < T; row0 += 2 * X.ngw) {
        f32x4 v[2][8];
#pragma unroll
        for (int r = 0; r < 2; ++r) { const int row = row0 + r * X.ngw; if (row < T) { const float* xp = xio + (size_t)row * D; const bf16_t* yp = y + (size_t)row * D;
#pragma unroll
            for (int j = 0; j < 4; ++j) { const int col = 8 * (X.lane + 64 * j); const u32x4 yy = *(const u32x4*)(yp + col);
                v[r][2 * j] = *(const f32x4*)(xp + col) + (f32x4){bf_lo(yy.x), bf_hi(yy.x), bf_lo(yy.y), bf_hi(yy.y)};
                v[r][2 * j + 1] = *(const f32x4*)(xp + col + 4) + (f32x4){bf_lo(yy.z), bf_hi(yy.z), bf_lo(yy.w), bf_hi(yy.w)}; } } }
#pragma unroll
        for (int r = 0; r < 2; ++r) { const int row = row0 + r * X.ngw; if (row < T) { float* xp = xio + (size_t)row * D; float ss = 0.f;
#pragma unroll
            for (int j = 0; j < 8; ++j) ss += v[r][j][0] * v[r][j][0] + v[r][j][1] * v[r][j][1] + v[r][j][2] * v[r][j][2] + v[r][j][3] * v[r][j][3];
            ss = wave_sum(ss); const float rstd = rsqrtf(ss * (1.0f / D) + EPS);
#pragma unroll
            for (int j = 0; j < 4; ++j) { const int col = 8 * (X.lane + 64 * j); const f32x4 g0 = *(const f32x4*)(gain + col), g1 = *(const f32x4*)(gain + col + 4);
                *(f32x4*)(xp + col) = v[r][2 * j] * rstd * g0; *(f32x4*)(xp + col + 4) = v[r][2 * j + 1] * rstd * g1; } } }
    }
}

__device__ __forceinline__ void scan_phase(const Ctx& X, bf16_t* BP, const float* l2g) {
    const int gt = blockIdx.x * NT + X.tid;
    for (int i = gt; i < 8 * 512 * 32; i += X.G * NT) {
        const int dg = i & 31, e = (i >> 5) & 511, h = i >> 14;
        const float cd = exp2f(256.0f * l2g[h]);
        bf16_t* p = BP + ((size_t)h * 64 * 512 + e) * 512 + dg * 8;
        float carry[8];
#pragma unroll
        for (int j = 0; j < 8; ++j) carry[j] = 0.f;
#pragma unroll 8
        for (int n = 0; n < 64; ++n) { bf16_t* q = p + (size_t)n * 512 * 512; const u32x4 uu = *(const u32x4*)q;
            u32x4 w; w.x = cvt_pk_bf16(carry[0], carry[1]); w.y = cvt_pk_bf16(carry[2], carry[3]); w.z = cvt_pk_bf16(carry[4], carry[5]); w.w = cvt_pk_bf16(carry[6], carry[7]);
            *(u32x4*)q = w;
            carry[0] = carry[0] * cd + bf_lo(uu.x); carry[1] = carry[1] * cd + bf_hi(uu.x); carry[2] = carry[2] * cd + bf_lo(uu.y); carry[3] = carry[3] * cd + bf_hi(uu.y);
            carry[4] = carry[4] * cd + bf_lo(uu.z); carry[5] = carry[5] * cd + bf_hi(uu.z); carry[6] = carry[6] * cd + bf_lo(uu.w); carry[7] = carry[7] * cd + bf_hi(uu.w); }
    }
}

__device__ __forceinline__ void normgate_phase(const Ctx& X, const bf16_t* O, bf16_t* GG, const f32x2* stats) {
    const int col = X.tid * 8, h = X.tid >> 6;
    for (int s0 = blockIdx.x * 4; s0 < SEQ; s0 += X.G * 4) {
        u32x4 ov[4], gv[4]; f32x4 stv[4][4];
#pragma unroll
        for (int r = 0; r < 4; ++r) { const int s = s0 + r; ov[r] = *(const u32x4*)(O + (size_t)s * RV + col); gv[r] = *(const u32x4*)(GG + (size_t)s * RV + col);
            const f32x4* st = (const f32x4*)(stats + ((size_t)s * 8 + h) * 8);
#pragma unroll
            for (int j = 0; j < 4; ++j) stv[r][j] = st[j]; }
#pragma unroll
        for (int r = 0; r < 4; ++r) { const int s = s0 + r; float s1 = 0.f, s2 = 0.f;
#pragma unroll
            for (int j = 0; j < 4; ++j) { s1 += stv[r][j][0] + stv[r][j][2]; s2 += stv[r][j][1] + stv[r][j][3]; }
            const float mu = s1 * (1.0f / 512.0f), var = fmaxf(s2 * (1.0f / 512.0f) - mu * mu, 0.f), rstd = rsqrtf(var + EPS);
            const unsigned ow[4] = {ov[r].x, ov[r].y, ov[r].z, ov[r].w}, gw[4] = {gv[r].x, gv[r].y, gv[r].z, gv[r].w}; unsigned rr[4];
#pragma unroll
            for (int j = 0; j < 4; ++j) { const float a0 = bf_lo(gw[j]) * ((bf_lo(ow[j]) - mu) * rstd), a1 = bf_hi(gw[j]) * ((bf_hi(ow[j]) - mu) * rstd); rr[j] = cvt_pk_bf16(a0, a1); }
            *(u32x4*)(GG + (size_t)s * RV + col) = (u32x4){rr[0], rr[1], rr[2], rr[3]}; }
    }
}

constexpr int KP = 272, VP = 528, LDS_V = 256 * KP;
__device__ __forceinline__ void attn_load_block(const bf16_t* ACT, int g, int hh, int bl, int cbq, int tid, u32x4 (&kreg)[4], u32x4 (&vreg)[4], bf16x8 (&qf)[4], bool want_q) {
    const bf16_t* Kg = ACT + (size_t)(g * 3 + 1) * SEQ * D; const bf16_t* VTg = ACT + (size_t)(g * 3 + 2) * SEQ * D;
    if (want_q) { const int lane = tid & 63, w = tid >> 6, n = lane & 15, q = lane >> 4; const bf16_t* qrow = ACT + (size_t)(g * 3) * SEQ * D + (size_t)(cbq * 128 + 16 * w + n) * D + hh * 128;
#pragma unroll
      for (int ks = 0; ks < 4; ++ks) qf[ks] = *(const bf16x8*)(qrow + 32 * ks + 8 * q); }
    const int row = tid >> 4, seg = tid & 15;
#pragma unroll
    for (int it = 0; it < 4; ++it) kreg[it] = *(const u32x4*)(Kg + (size_t)(bl * 128 + row + 32 * it) * D + hh * 128 + seg * 8);
#pragma unroll
    for (int it = 0; it < 4; ++it) vreg[it] = *(const u32x4*)(VTg + (size_t)(hh * 128 + row + 32 * it) * SEQ + bl * 128 + seg * 8);
}
__device__ __forceinline__ void attn_phase(const Ctx& X, bf16_t* ACT, float* LSE, bf16_t* Hb, const int g_lo, const int g_hi, const bool fuse) {
    const int tid = X.tid, lane = X.lane, w = X.wave, n = lane & 15, q = lane >> 4;
    const int nruns = (g_hi - g_lo) * 16 * 16;
    u32x4 kreg[4], vreg[4]; bf16x8 qn[4];
    const int lrow = tid >> 4, lseg = tid & 15;
#pragma unroll 1
    for (int run = X.vcu; run < nruns; run += X.G) {
        const int g = g_lo + (run >> 8), hh = (run >> 4) & 15, cb0 = (run & 15) * 8; const int nb = 128 >> (2 * g);
        attn_load_block(ACT, g, hh, cb0 > 0 ? cb0 - 1 : 0, 0, tid, kreg, vreg, qn, false);
#pragma unroll 1
        for (int step = 0; step < 9; ++step) {
            const int bl = cb0 - 1 + step, slot = bl & 1;
#pragma unroll
            for (int it = 0; it < 4; ++it) *(LAS u32x4*)(X.lds + (slot * 128 + lrow + 32 * it) * KP + lseg * 16) = kreg[it];
#pragma unroll
            for (int it = 0; it < 4; ++it) *(LAS u32x4*)(X.lds + LDS_V + (lrow + 32 * it) * VP + slot * 256 + lseg * 16) = vreg[it];
            __syncthreads();
            bf16x8 qf[4];
#pragma unroll
            for (int ks = 0; ks < 4; ++ks) qf[ks] = qn[ks];
            if (step < 8) attn_load_block(ACT, g, hh, cb0 + step, cb0 + step, tid, kreg, vreg, qn, true);
            if (step >= 1) {
                const int cb = cb0 + step - 1; const bool hp = (cb & (nb - 1)) != 0; const int par = (cb + 1) & 1;
                bf16_t* qrow = ACT + (size_t)(g * 3) * SEQ * D + (size_t)(cb * 128 + 16 * w + n) * D + hh * 128;
                f32x4 sacc[10];
                const int i = 16 * w + n;
#pragma unroll
                for (int kb = 0; kb < 9; ++kb) {
                    const int j0 = 16 * w + 16 * kb; const int r0 = ((((j0 >> 7) ^ par) & 1) << 7) + (j0 & 127);
                    f32x4 sv = (f32x4){0.f, 0.f, 0.f, 0.f};
#pragma unroll
                    for (int ks = 0; ks < 4; ++ks) { const bf16x8 kf = *(const LAS bf16x8*)(X.lds + (r0 + n) * KP + (32 * ks + 8 * q) * 2); sv = __builtin_amdgcn_mfma_f32_16x16x32_bf16(kf, qf[ks], sv, 0, 0, 0); }
                    const bool blk_ok = hp || (j0 >= 128);
#pragma unroll
                    for (int jj = 0; jj < 4; ++jj) { bool valid = blk_ok;
                        if (kb == 0) valid = valid && (4 * q + jj >= n);
                        if (kb == 8) valid = valid && (4 * q + jj <= n);
                        sv[jj] = valid ? sv[jj] : -INFINITY; }
                    sacc[kb] = sv;
                }
                float mx = -INFINITY;
#pragma unroll
                for (int kb = 0; kb < 9; ++kb)
#pragma unroll
                    for (int jj = 0; jj < 4; ++jj) mx = fmaxf(mx, sacc[kb][jj]);
                mx = fmaxf(mx, __shfl_xor(mx, 16)); mx = fmaxf(mx, __shfl_xor(mx, 32));
                const float sc2 = 0.08838834764831845f * 1.4426950408889634f; float l = 0.f;
#pragma unroll
                for (int kb = 0; kb < 9; ++kb)
#pragma unroll
                    for (int jj = 0; jj < 4; ++jj) { const float p = __builtin_amdgcn_exp2f((sacc[kb][jj] - mx) * sc2); sacc[kb][jj] = p; l += p; }
                sacc[9] = (f32x4){0.f, 0.f, 0.f, 0.f};
                l += __shfl_xor(l, 16); l += __shfl_xor(l, 32);
                f32x4 oacc[8];
#pragma unroll
                for (int eb = 0; eb < 8; ++eb) oacc[eb] = (f32x4){0.f, 0.f, 0.f, 0.f};
#pragma unroll
                for (int s2 = 0; s2 < 5; ++s2) {
                    const int ja = 16 * w + 32 * s2, jb = ja + 16; const int jac = ja > 240 ? 240 : ja, jbc = jb > 240 ? 240 : jb;
                    const int ca = ((((jac >> 7) ^ par) & 1) << 7) + (jac & 127), cbb = ((((jbc >> 7) ^ par) & 1) << 7) + (jbc & 127);
                    u32x4 pw; pw.x = cvt_pk_bf16(sacc[2 * s2][0], sacc[2 * s2][1]); pw.y = cvt_pk_bf16(sacc[2 * s2][2], sacc[2 * s2][3]);
                    pw.z = cvt_pk_bf16(sacc[2 * s2 + 1][0], sacc[2 * s2 + 1][1]); pw.w = cvt_pk_bf16(sacc[2 * s2 + 1][2], sacc[2 * s2 + 1][3]);
                    const bf16x8 pf = __builtin_bit_cast(bf16x8, pw);
#pragma unroll
                    for (int eb = 0; eb < 8; ++eb) { const int e = 16 * eb + n;
                        const u32x2 va = *(const LAS u32x2*)(X.lds + LDS_V + e * VP + (ca + 4 * q) * 2), vb = *(const LAS u32x2*)(X.lds + LDS_V + e * VP + (cbb + 4 * q) * 2);
                        const u32x4 vv = (u32x4){va.x, va.y, vb.x, vb.y};
                        oacc[eb] = __builtin_amdgcn_mfma_f32_16x16x32_bf16(__builtin_bit_cast(bf16x8, vv), pf, oacc[eb], 0, 0, 0); }
                }
                const float il = 1.0f / l; const float lse_own = mx * 0.08838834764831845f + __logf(l);
                const int ecol = (q & 1) ? 16 + 4 * (q - 1) : 4 * q;
                if (!fuse) {
#pragma unroll
                    for (int eb = 0; eb < 8; eb += 2) {
                        const unsigned a0 = cvt_pk_bf16(oacc[eb][0] * il, oacc[eb][1] * il), a1 = cvt_pk_bf16(oacc[eb][2] * il, oacc[eb][3] * il);
                        const unsigned b0 = cvt_pk_bf16(oacc[eb + 1][0] * il, oacc[eb + 1][1] * il), b1 = cvt_pk_bf16(oacc[eb + 1][2] * il, oacc[eb + 1][3] * il);
                        const auto s0 = __builtin_amdgcn_permlane16_swap(a0, b0, false, false), s1 = __builtin_amdgcn_permlane16_swap(a1, b1, false, false);
                        *(u32x4*)(qrow + 16 * eb + ecol) = (u32x4){s0[0], s1[0], s0[1], s1[1]}; }
                    if (q == 0) LSE[((size_t)g * SEQ + cb * 128 + i) * 16 + hh] = lse_own;
                } else {
                    const int c2 = cb * 128 + i, t = ((c2 & 1023) << 4) + (c2 >> 10), c1 = ((t & 3) << 12) + (t >> 2);
                    const float l0 = LSE[((size_t)0 * SEQ + t) * 16 + hh], l1 = LSE[((size_t)1 * SEQ + c1) * 16 + hh];
                    const bf16_t* o0 = ACT + (size_t)t * D + hh * 128 + ecol; const bf16_t* o1 = ACT + (size_t)3 * SEQ * D + (size_t)c1 * D + hh * 128 + ecol;
                    u32x4 a0[4], a1[4];
#pragma unroll
                    for (int ep = 0; ep < 4; ++ep) { a0[ep] = *(const u32x4*)(o0 + 32 * ep); a1[ep] = *(const u32x4*)(o1 + 32 * ep); }
                    const float mm = fmaxf(lse_own, fmaxf(l0, l1)); const float e0 = __expf(l0 - mm), e1 = __expf(l1 - mm), e2 = __expf(lse_own - mm);
                    const float iw = 1.0f / (e0 + e1 + e2); const float w0 = e0 * iw, w1 = e1 * iw, w2 = e2 * iw * il;
                    bf16_t* orow = Hb + (size_t)t * D + hh * 128 + ecol;
#pragma unroll
                    for (int ep = 0; ep < 4; ++ep) { const int eb = 2 * ep;
                        const auto p0x = __builtin_amdgcn_permlane16_swap(a0[ep].x, a0[ep].z, false, false), p0y = __builtin_amdgcn_permlane16_swap(a0[ep].y, a0[ep].w, false, false);
                        const auto p1x = __builtin_amdgcn_permlane16_swap(a1[ep].x, a1[ep].z, false, false), p1y = __builtin_amdgcn_permlane16_swap(a1[ep].y, a1[ep].w, false, false);
                        const unsigned r0 = cvt_pk_bf16(w0 * bf_lo(p0x[0]) + w1 * bf_lo(p1x[0]) + w2 * oacc[eb][0], w0 * bf_hi(p0x[0]) + w1 * bf_hi(p1x[0]) + w2 * oacc[eb][1]);
                        const unsigned r1 = cvt_pk_bf16(w0 * bf_lo(p0y[0]) + w1 * bf_lo(p1y[0]) + w2 * oacc[eb][2], w0 * bf_hi(p0y[0]) + w1 * bf_hi(p1y[0]) + w2 * oacc[eb][3]);
                        const unsigned r2 = cvt_pk_bf16(w0 * bf_lo(p0x[1]) + w1 * bf_lo(p1x[1]) + w2 * oacc[eb + 1][0], w0 * bf_hi(p0x[1]) + w1 * bf_hi(p1x[1]) + w2 * oacc[eb + 1][1]);
                        const unsigned r3 = cvt_pk_bf16(w0 * bf_lo(p0y[1]) + w1 * bf_lo(p1y[1]) + w2 * oacc[eb + 1][2], w0 * bf_hi(p0y[1]) + w1 * bf_hi(p1y[1]) + w2 * oacc[eb + 1][3]);
                        const auto s0 = __builtin_amdgcn_permlane16_swap(r0, r2, false, false), s1 = __builtin_amdgcn_permlane16_swap(r1, r3, false, false);
                        *(u32x4*)(orow + 32 * ep) = (u32x4){s0[0], s1[0], s0[1], s1[1]}; }
                }
            }
            __syncthreads();
        }
    }
}
__device__ __forceinline__ void combine_phase(const Ctx& X, const bf16_t* ACT, const float* LSE, bf16_t* Hb) {
    const int col = X.tid * 4, hh = X.tid >> 5;
    for (int s0 = blockIdx.x * 8; s0 < SEQ; s0 += X.G * 8) {
        float ls[8][3]; u32x2 ov[8][3];
#pragma unroll
        for (int r = 0; r < 8; ++r) { const int s = s0 + r;
#pragma unroll
            for (int g = 0; g < 3; ++g) { const int ld = 2 * g, lL = 14 - ld; const int c = ((s & ((1 << ld) - 1)) << lL) + (s >> ld);
                ls[r][g] = LSE[((size_t)g * SEQ + c) * 16 + hh]; ov[r][g] = *(const u32x2*)(ACT + (size_t)(g * 3) * SEQ * D + (size_t)c * D + col); } }
#pragma unroll
        for (int r = 0; r < 8; ++r) { const int s = s0 + r;
            const float mx = fmaxf(ls[r][0], fmaxf(ls[r][1], ls[r][2])); float wg[3], wsum = 0.f;
#pragma unroll
            for (int g = 0; g < 3; ++g) { wg[g] = __expf(ls[r][g] - mx); wsum += wg[g]; }
            const float iw = 1.0f / wsum; float o[4] = {0.f, 0.f, 0.f, 0.f};
#pragma unroll
            for (int g = 0; g < 3; ++g) { const float ww = wg[g] * iw; o[0] += ww * bf_lo(ov[r][g].x); o[1] += ww * bf_hi(ov[r][g].x); o[2] += ww * bf_lo(ov[r][g].y); o[3] += ww * bf_hi(ov[r][g].y); }
            u32x2 rr; rr.x = cvt_pk_bf16(o[0], o[1]); rr.y = cvt_pk_bf16(o[2], o[3]); *(u32x2*)(Hb + (size_t)s * D + col) = rr; }
    }
}

__global__ void __launch_bounds__(NT, 2) fwd_megakernel(Args a) {
    extern __shared__ __attribute__((aligned(16))) unsigned char lds_raw[];
    cg::grid_group grid = cg::this_grid();
    Ctx X; X.G = gridDim.x; X.ngw = X.G * 8; X.lds = (LAS unsigned char*)lds_raw;
#define REFRESH() do { int t_ = threadIdx.x; asm volatile("" : "+v"(t_)); int bx_ = blockIdx.x; asm volatile("" : "+s"(bx_)); X.tid = t_; X.lane = t_ & 63; X.wave = __builtin_amdgcn_readfirstlane(t_ >> 6); \
        X.vcu = (X.G % 8 == 0) ? (bx_ % 8) * (X.G / 8) + bx_ / 8 : bx_; X.gw = bx_ * 8 + X.wave; } while (0)
    REFRESH();
    unsigned char* ws = a.ws;
    bf16_t* Wt = (bf16_t*)(ws + WS_W); bf16_t* H = (bf16_t*)(ws + WS_H); bf16_t* ACT = (bf16_t*)(ws + WS_ACT);
    float* MOD = (float*)(ws + WS_MOD); float* L2G = (float*)(ws + WS_L2G); f32x2* STATS = (f32x2*)(ws + WS_STATS); float* LSE = (float*)(ws + WS_LSE);
    using namespace pg8;
#define SYNC() xcd_barrier(xbar)

    { volatile LAS unsigned* st = (volatile LAS unsigned*)(X.lds + LDS_MISC); if (X.tid < 4) st[X.tid] = 0u; __syncthreads(); }
    XcdBarrier xbar = xcd_barrier_post((unsigned*)(ws + WS_BAR), (volatile LAS unsigned*)(X.lds + LDS_MISC));
    { LAS float* tab = (LAS float*)(X.lds + 131072);
      if (X.tid < 144) tab[X.tid] = X.tid < 128 ? a.invf_ret[X.tid] : a.invf_att[X.tid - 128];
      if (blockIdx.x == 0 && X.tid < 8) L2G[X.tid] = a.l2g[X.tid];
      __syncthreads(); }

    tables_phase(X, a);
    modp_phase(X, a);
    grid.sync();
    modfin_phase(X, a);

#pragma unroll 1
    for (int layer = 0; layer < 2; ++layer) {
        REFRESH();
        const float* MODL = MOD + (size_t)layer * 2 * 12288;
        { int base = 0;
          if (layer == 0) { transpose_items(X, a.ret_w_in, D, RPROJ, Wt + W0_RIN, base); transpose_items(X, a.ret_w_out, RV, D, Wt + W0_ROUT, base); }
          else            { transpose_items(X, a.att_w_in, D, APROJ, Wt + W1_AIN, base); transpose_items(X, a.att_w_out, D, D, Wt + W1_AOUT, base); }
          const size_t w1o = layer == 0 ? W0_1 : W1_1, w2o = layer == 0 ? W0_2 : W1_2;
          transpose_items(X, a.mlp_w1 + (size_t)layer * D * DFF, D, DFF, Wt + w1o, base);
          transpose_items(X, a.mlp_w2 + (size_t)layer * D * DFF, DFF, D, Wt + w2o, base); }
        SYNC();
        const float* xin = layer == 0 ? a.x : a.out;
        if (layer == 0) {
#pragma unroll 1
            for (int b = 0; b < NB; ++b) {
                REFRESH();
                bf16_t* Hb = H + (size_t)b * SEQ * D;
                if (b == 0) { norm_mod_phase(X, xin, a.norm_mix, MODL, 0, H, 0, T); SYNC(); }
                const f32x4* csr = (const f32x4*)(ws + WS_CSR + (size_t)b * SEQ * 128 * 8); const f32x4* csrt = (const f32x4*)(ws + WS_CSRT + (size_t)b * SEQ * 128 * 8);
#pragma unroll 1
                for (int qk = 0; qk < 2; ++qk) {
                    Gemm g{Hb, Wt + W0_RIN + (size_t)qk * 2048 * D, D, D, D}; auto S = mk_sched(64, 8, MapRetQK{qk == 0 ? 131072u : 65536u});
                    EpiRetQK E{ACT + (qk == 0 ? A_AP : A_KT), qk == 0 ? 512 : 256, csr, qk, L2G, ACT + A_KZ};
                    gemm_phase(X.lds, g, S, E); }
                {
                    Gemm g{Wt + W0_RIN + (size_t)4096 * D, Hb, D, D, D}; auto S = mk_sched(16, 64, MapVT0{});
                    EpiBf16<0> E{ACT + A_BP, 512}; gemm_phase(X.lds, g, S, E); }
                SYNC();
                {
                    Gemm g{ACT + A_AP, ACT + A_KT, 512, 256, 256}; auto S = mk_sched(512, 1, MapP{});
                    EpiP E{ACT + A_AP, L2G};
                    gemm_phase(X.lds, g, S, E); }
                {
                    Gemm g{ACT + A_BP, ACT + A_KZ, 512, 256, 256}; auto S = mk_sched(1024, 1, MapU{});
                    EpiBf16<0> E{ACT + A_BP, 512}; gemm_phase(X.lds, g, S, E); }
                SYNC();
                scan_phase(X, ACT + A_BP, L2G);
                SYNC();
                {
                    Gemm g{ACT + A_AP, ACT + A_BP, 512, 512, 512}; auto S = mk_sched(512, 2, MapO{});
                    EpiO E{ACT + A_O, STATS}; gemm_phase(X.lds, g, S, E); }
                SYNC();
                {
                    Gemm g{Hb, Wt + W0_RIN + (size_t)8192 * D, D, D, D}; auto S = mk_sched(64, 16, MapG{});
                    EpiGate E{ACT + A_GG, ACT + A_O, STATS}; gemm_phase(X.lds, g, S, E); }
                SYNC();
                {
                    Gemm g{ACT + A_GG, Wt + W0_ROUT, RV, RV, RV}; auto S = mk_sched(64, 8, MapOut0{});
                    EpiRes E{a.x + (size_t)b * SEQ * D, a.out + (size_t)b * SEQ * D, MODL + (size_t)b * 12288 + 2 * D, 0}; gemm_phase(X.lds, g, S, E); }
                if (b == NB - 1) SYNC();
            }
        } else {
#pragma unroll 1
            for (int b = 0; b < NB; ++b) {
                REFRESH();
                bf16_t* Hb = H + (size_t)b * SEQ * D;
                if (b == 0) { norm_mod_phase(X, xin, a.norm_mix + D, MODL, 0, H, 0, T); SYNC(); }
                const f32x4* csa = (const f32x4*)(ws + WS_CSA + (size_t)b * SEQ * 16 * 8);
#pragma unroll 1
                for (int gq = 0; gq < 6; ++gq) {
                    const int gi = gq >> 1, qk = gq & 1, ld = 2 * gi, lL = 14 - ld, dil = 1 << ld;
                    Gemm g{Hb, Wt + W1_AIN + (size_t)(gi * 6144 + qk * 2048) * D, dil * D, D, D}; auto S = mk_sched(64, 8, MapAttQK{6 - ld, ld});
                    EpiAttQK E{ACT + (size_t)(gi * 3 + qk) * SEQ * D, csa, ld, lL}; gemm_phase(X.lds, g, S, E); }
#pragma unroll 1
                for (int gi = 0; gi < 3; ++gi) {
                    const int ld = 2 * gi, dil = 1 << ld;
                    Gemm g{Wt + W1_AIN + (size_t)(gi * 6144 + 4096) * D, Hb, D, dil * D, D}; auto S = mk_sched(8, 64, MapAttVT{6 - ld, ld});
                    EpiBf16<0> E{ACT + (size_t)(gi * 3 + 2) * SEQ * D, SEQ}; gemm_phase(X.lds, g, S, E); }
                SYNC();
#pragma unroll 1
                for (int ap = 0; ap < 2; ++ap) {
                    REFRESH();
                    attn_phase(X, ACT, LSE, Hb, ap == 0 ? 0 : 2, ap == 0 ? 2 : 3, ap == 1);
                    SYNC(); }
            }
            { Gemm g{H, Wt + W1_AOUT, D, D, D}; auto S = mk_sched(128, 8, MapOut1{});
              EpiRes E{a.out, a.out, MODL + 2 * D, 12288}; gemm_phase(X.lds, g, S, E); }
            SYNC();
        }
        norm_mod_phase(X, a.out, a.norm_mlp + layer * D, MODL, 3, H, 0, T);
        SYNC();
        { Gemm g{H, Wt + (layer == 0 ? W0_1 : W1_1), D, D, D}; auto S = mk_sched(128, 32, MapMlp1{});
          EpiBf16<2> E{ACT, DFF}; gemm_phase(X.lds, g, S, E);
#ifdef PROBE_A
          SYNC(); gemm_phase(X.lds, g, S, E);
#endif
        }
        SYNC();
        { Gemm g{ACT, Wt + (layer == 0 ? W0_2 : W1_2), DFF, DFF, DFF}; auto S = mk_sched(128, 8, MapMlp2{});
          if (layer == 0) { EpiRes E{a.out, a.out, MODL + 5 * D, 12288}; gemm_phase(X.lds, g, S, E); }
          else { EpiY E{H, MODL + 5 * D, 12288}; gemm_phase(X.lds, g, S, E); } }
        SYNC();
    }
    final_norm_phase(X, a.out, H, a.final_norm);
}

extern "C" void kernel_launch(void* const* d_in, const int* in_sizes, int n_in, void* d_out, int out_size, void* d_ws, size_t ws_size, hipStream_t stream) {
    static int grid = 0;
    if (grid == 0) {
        if (n_in != 14 || out_size != T * D || ws_size < WS_END) { fprintf(stderr, "kernel_launch: unexpected shapes (n_in %d out %d ws %zu need %zu)\n", n_in, out_size, ws_size, (size_t)WS_END); grid = -1; return; }
        int dev = 0, cus = 0, per_cu = 0;
        hipGetDevice(&dev); hipDeviceGetAttribute(&cus, hipDeviceAttributeMultiprocessorCount, dev);
        if (hipFuncSetAttribute((const void*)fwd_megakernel, hipFuncAttributeMaxDynamicSharedMemorySize, LDS_BYTES) != hipSuccess) { fprintf(stderr, "kernel_launch: hipFuncSetAttribute failed\n"); grid = -1; return; }
        hipOccupancyMaxActiveBlocksPerMultiprocessor(&per_cu, (const void*)fwd_megakernel, NT, LDS_BYTES);
        if (per_cu < 1) { fprintf(stderr, "kernel_launch: occupancy query says %d blocks/CU\n", per_cu); per_cu = 1; }
        grid = cus;
    }
    if (grid < 0) return;
    Args a{};
    a.x = (const float*)d_in[0]; a.c = (const float*)d_in[1]; a.pos = (const int*)d_in[2]; a.ada_w = (const float*)d_in[3]; a.ada_b = (const float*)d_in[4];
    a.norm_mix = (const float*)d_in[5]; a.norm_mlp = (const float*)d_in[6]; a.ret_w_in = (const float*)d_in[7]; a.ret_w_out = (const float*)d_in[8];
    a.att_w_in = (const float*)d_in[9]; a.att_w_out = (const float*)d_in[10]; a.mlp_w1 = (const float*)d_in[11]; a.mlp_w2 = (const float*)d_in[12]; a.final_norm = (const float*)d_in[13];
    a.out = (float*)d_out; a.ws = (unsigned char*)d_ws;
    for (int d = 0; d < 128; ++d) a.invf_ret[d] = (float)pow(10000.0, -(double)d / 128.0);
    for (int d = 0; d < 16; ++d) a.invf_att[d] = (float)pow(500000.0, -(double)d / 16.0);
    for (int h = 0; h < 8; ++h) a.l2g[h] = (float)log2(1.0 - exp2(-5.0 - (double)h));
    if (hipMemsetAsync((char*)d_ws + WS_BAR, 0, BAR_BYTES, stream) != hipSuccess) { fprintf(stderr, "kernel_launch: memset failed\n"); return; }
    void* args[] = {&a};
    hipError_t e = hipLaunchCooperativeKernel((const void*)fwd_megakernel, dim3(grid), dim3(NT), args, LDS_BYTES, stream);
    if (e != hipSuccess) fprintf(stderr, "cooperative launch failed: %s (grid %d)\n", hipGetErrorString(e), grid);
}
```

```cpp
#include <hip/hip_runtime.h>
#include <hip/hip_cooperative_groups.h>
#include <cstdio>
#include <cmath>
namespace cg = cooperative_groups;

#define LAS __attribute__((address_space(3)))
typedef unsigned short bf16_t;
typedef short bf16x8 __attribute__((ext_vector_type(8)));
typedef float f32x4 __attribute__((ext_vector_type(4)));
typedef float f32x2 __attribute__((ext_vector_type(2)));
typedef unsigned u32x4 __attribute__((ext_vector_type(4)));
typedef unsigned u32x2 __attribute__((ext_vector_type(2)));

constexpr int D = 2048, SEQ = 16384, NB = 2, T = NB * SEQ, DFF = 8192;
constexpr int RPROJ = 12288, APROJ = 18432, RV = 4096;
constexpr float EPS = 1e-6f;
constexpr int NT = 512;
constexpr int LDS_MISC = 137216;
constexpr int LDS_BYTES = LDS_MISC + 256;

constexpr size_t WS_W      = 0;
constexpr size_t W_BYTES   = 150994944;
constexpr size_t WS_CSR    = WS_W + W_BYTES;
constexpr size_t WS_CSRT   = WS_CSR + (size_t)2 * SEQ * 128 * 8;
constexpr size_t WS_CSA    = WS_CSRT + (size_t)2 * SEQ * 128 * 8;
constexpr size_t WS_MODP   = WS_CSA + (size_t)2 * SEQ * 16 * 8;
constexpr size_t WS_MOD    = WS_MODP + (size_t)16 * 4 * 12288 * 4;
constexpr size_t WS_STATS  = WS_MOD + (size_t)4 * 12288 * 4;
constexpr size_t WS_LSE    = WS_STATS + (size_t)SEQ * 128 * 4;
constexpr size_t WS_L2G    = WS_LSE + (size_t)3 * SEQ * 16 * 4;
constexpr size_t WS_BAR    = WS_L2G + 256;
constexpr size_t BAR_BYTES = 16384;
constexpr size_t WS_H      = WS_BAR + BAR_BYTES;
constexpr size_t WS_ACT    = WS_H + (size_t)T * D * 2;
constexpr size_t ACT_BYTES = 671088640;
constexpr size_t WS_END    = WS_ACT + ACT_BYTES;
constexpr size_t A_AP = 0;
constexpr size_t A_BP = A_AP + (size_t)512 * 256 * 512;
constexpr size_t A_KT = A_BP + (size_t)512 * 512 * 512;
constexpr size_t A_KZ = A_KT + (size_t)512 * 65536;
constexpr size_t A_O  = A_KT;
constexpr size_t A_GG = A_KZ + (size_t)512 * 65536;
constexpr size_t W0_RIN = 0, W0_ROUT = W0_RIN + (size_t)RPROJ * D, W0_1 = W0_ROUT + (size_t)D * RV, W0_2 = W0_1 + (size_t)DFF * D;
constexpr size_t W1_AIN = 0, W1_AOUT = W1_AIN + (size_t)APROJ * D, W1_1 = W1_AOUT + (size_t)D * D, W1_2 = W1_1 + (size_t)DFF * D;

struct Args {
    const float* x; const float* c; const int* pos; const float* ada_w; const float* ada_b; const float* norm_mix; const float* norm_mlp;
    const float* ret_w_in; const float* ret_w_out; const float* att_w_in; const float* att_w_out; const float* mlp_w1; const float* mlp_w2; const float* final_norm;
    float* out; unsigned char* ws;
    float invf_ret[128]; float invf_att[16]; float l2g[8];
};

__device__ __forceinline__ unsigned cvt_pk_bf16(float lo, float hi) { unsigned r; asm volatile("v_cvt_pk_bf16_f32 %0, %1, %2" : "=v"(r) : "v"(lo), "v"(hi)); return r; }
__device__ __forceinline__ float bf_lo(unsigned w) { return __uint_as_float(w << 16); }
__device__ __forceinline__ float bf_hi(unsigned w) { return __uint_as_float(w & 0xffff0000u); }
__device__ __forceinline__ float wave_sum(float v) {
#pragma unroll
    for (int o = 32; o >= 1; o >>= 1) v += __shfl_xor(v, o);
    return v;
}
__device__ __forceinline__ float silu_f(float v) { return v / (1.0f + __expf(-v)); }


#define XB_TMO      128
#define XB_XCNT(j)  (256  + 64 * (j))
#define XB_XSUB(j)  (1280 + 64 * (j))
#define XB_XGEN(j)  (2304 + 64 * (j))
#define XB_TOP      3328
#define XB_TOPGEN   3392
#define XCD_BAR_WORDS 3456
#define XB_SPIN_CAP (1u << 18)
__device__ __forceinline__ unsigned xb_ld(unsigned* p)              { return __hip_atomic_load(p, __ATOMIC_RELAXED, __HIP_MEMORY_SCOPE_AGENT); }
__device__ __forceinline__ unsigned xb_add(unsigned* p, unsigned v) { return __hip_atomic_fetch_add(p, v, __ATOMIC_RELAXED, __HIP_MEMORY_SCOPE_AGENT); }
__device__ __forceinline__ unsigned xb_xcc_id() { return (unsigned)__builtin_amdgcn_s_getreg((3 << 11) | 20) & 0xFu; }
#define XB_SPIN(cond, bar) do { unsigned _sp = 0; while (cond) { __builtin_amdgcn_s_sleep(1); \
    if ((++_sp & 255u) == 0u) { if (xb_ld(&(bar)[XB_TMO])) break; if (_sp > XB_SPIN_CAP) { atomicAdd(&(bar)[XB_TMO], 1u); break; } } } } while (0)
struct XcdBarrier { unsigned* bar; unsigned x; volatile LAS unsigned* st; };
__device__ __forceinline__ XcdBarrier xcd_barrier_post(unsigned* bar, volatile LAS unsigned* st) {
    XcdBarrier b; b.bar = bar; b.x = xb_xcc_id(); b.st = st;
    if (threadIdx.x == 0) (void)xb_add(&bar[XB_XCNT(b.x)], 1u);
    return b;
}
__device__ __forceinline__ void xcd_barrier_complete(unsigned* bar, unsigned x, unsigned& nloc, unsigned& nx) {
    const unsigned G = gridDim.x * gridDim.y * gridDim.z;
    unsigned sum, cnt, mine, sp = 0u;
    for (;;) {
        sum = 0u; cnt = 0u; mine = 0u;
#pragma unroll
        for (unsigned j = 0; j < 16; ++j) { const unsigned c = xb_ld(&bar[XB_XCNT(j)]); sum += c; cnt += (c > 0u) ? 1u : 0u; mine = (j == x) ? c : mine; }
        if (sum == G) break;
        __builtin_amdgcn_s_sleep(1);
        if ((++sp & 255u) == 0u) { if (xb_ld(&bar[XB_TMO])) break; if (sp > XB_SPIN_CAP) { atomicAdd(&bar[XB_TMO], 1u); break; } }
    }
    nloc = mine > 0u ? mine : 1u; nx = cnt > 0u ? cnt : 1u;
}
__device__ __forceinline__ void xcd_barrier(const XcdBarrier& b) {
    asm volatile("s_waitcnt vmcnt(0)" ::: "memory");
    __syncthreads();
    if (threadIdx.x == 0) {
        unsigned* bar = b.bar;
        __builtin_amdgcn_s_waitcnt(0);
        unsigned nloc = b.st[0], nx = b.st[1];
        if (nloc == 0u) { xcd_barrier_complete(bar, b.x, nloc, nx); b.st[0] = nloc; b.st[1] = nx; }
        const unsigned old = xb_add(&bar[XB_XSUB(b.x)], 1u);
        const unsigned gen = old / nloc;
        if (old + 1u == (gen + 1u) * nloc) {
            __builtin_amdgcn_fence(__ATOMIC_RELEASE, "agent");
            asm volatile("s_waitcnt vmcnt(0)" ::: "memory");
            const unsigned og = xb_add(&bar[XB_TOP], 1u);
            const unsigned tg = og / nx;
            if (og + 1u == (tg + 1u) * nx) xb_add(&bar[XB_TOPGEN], 1u);
            else XB_SPIN(xb_ld(&bar[XB_TOPGEN]) == tg, bar);
            __builtin_amdgcn_fence(__ATOMIC_ACQUIRE, "agent");
            xb_add(&bar[XB_XGEN(b.x)], 1u);
            asm volatile("s_waitcnt vmcnt(0)" ::: "memory");
        } else {
            XB_SPIN(xb_ld(&bar[XB_XGEN(b.x)]) == gen, bar);
            __builtin_amdgcn_fence(__ATOMIC_ACQUIRE, "agent");
            asm volatile("s_waitcnt vmcnt(0)" ::: "memory");
        }
    }
    __syncthreads();
}

namespace pg8 {
constexpr int BM = 256, BK = 64, HALF = 128, HTB = HALF * BK * 2, STAGE_BYTES = 8 * HTB, NXCD = 8, WGM = 8;
__device__ __forceinline__ int lds_byte(int r, int c) { const int st = (r >> 4) * 2 + (c >> 5), rr = r & 15, cc = c & 31, ob = rr * 64 + cc * 2; return st * 1024 + (ob ^ (((ob >> 9) & 1) << 5)); }
__device__ __forceinline__ void stage_rc(int b, int& R, int& C) { const int st = b / 1024, sb = b % 1024, swz = sb ^ (((sb >> 9) & 1) << 5); R = (st >> 1) * 16 + swz / 64; C = (st & 1) * 32 + (swz % 64) / 2; }
__device__ __forceinline__ int perm32(int rho) { const int n = rho >> 4, i = rho & 15; return 8 * (i >> 2) + 4 * n + (i & 3); }

struct Unit { unsigned aoff, boff, coff; int pm, pn; };
struct Gemm { const bf16_t* A; const bf16_t* Bt; int lda, ldb, K; };

template <class Map> struct Sched {
    int nM, nN, nwg, G, c; Map map;
    __device__ __forceinline__ bool next(int i, Unit& u) const {
        const long L = (long)i * G + c; if (L >= nwg) return false;
        int wgid = (int)L; { const int q = nwg / NXCD, r = nwg % NXCD, xcd = wgid % NXCD, off = wgid / NXCD; wgid = (xcd < r ? xcd * (q + 1) : r * (q + 1) + (xcd - r) * q) + off; }
        const int nig = WGM * nN, gid = wgid / nig, fm = gid * WGM, gsz = (nM - fm) < WGM ? (nM - fm) : WGM;
        u.pm = fm + ((wgid % nig) % gsz); u.pn = (wgid % nig) / gsz;
        map(u.pm, u.pn, u);
        return true;
    }
};
template <class Map> __device__ __forceinline__ Sched<Map> mk_sched(int nM, int nN, Map m) { Sched<Map> s; s.nM = nM; s.nN = nN; s.nwg = nM * nN; s.G = gridDim.x; s.c = blockIdx.x; s.map = m; return s; }
constexpr unsigned MB1 = 1048576u;
struct MapRetQK { unsigned tile; __device__ __forceinline__ void operator()(int pm, int pn, Unit& u) const { u.aoff = pm * MB1; u.boff = pn * MB1; u.coff = (unsigned)(pn * 64 + pm) * tile; } };
struct MapKzT { __device__ __forceinline__ void operator()(int pm, int pn, Unit& u) const { u.aoff = pm * MB1; u.boff = pn * MB1; u.coff = (unsigned)(pm * 64 + pn) * 65536u; } };
struct MapVT0 { __device__ __forceinline__ void operator()(int pm, int pn, Unit& u) const { u.aoff = pm * MB1; u.boff = pn * MB1; u.coff = 256u + (unsigned)((pm >> 1) * 64 + pn) * 262144u + (unsigned)(pm & 1) * 131072u; } };
struct MapG { __device__ __forceinline__ void operator()(int pm, int pn, Unit& u) const { u.aoff = pm * MB1; u.boff = pn * MB1; u.coff = (unsigned)pm * (256u * 4096u) + pn * 256u; } };
struct MapP { __device__ __forceinline__ void operator()(int pm, int pn, Unit& u) const { u.aoff = pm * 262144u; u.boff = pm * 131072u; u.coff = 256u + pm * 131072u; } };
struct MapU { __device__ __forceinline__ void operator()(int pm, int pn, Unit& u) const { u.aoff = 512u + pm * 262144u; u.boff = (unsigned)(pm >> 1) * 131072u; u.coff = pm * 131072u; } };
struct MapO { __device__ __forceinline__ void operator()(int pm, int pn, Unit& u) const { u.aoff = pm * 262144u; u.boff = pm * 524288u + pn * 262144u; u.coff = (unsigned)(pm >> 6) * 512u + (unsigned)(pm & 63) * (256u * 4096u) + pn * 256u; } };
struct MapOut0 { __device__ __forceinline__ void operator()(int pm, int pn, Unit& u) const { u.aoff = pm * (2u * MB1); u.boff = pn * (2u * MB1); u.coff = 0; } };
struct MapMlp1 { __device__ __forceinline__ void operator()(int pm, int pn, Unit& u) const { u.aoff = pm * MB1; u.boff = pn * MB1; u.coff = (unsigned)pm * (256u * 8192u) + pn * 256u; } };
struct MapMlp2 { __device__ __forceinline__ void operator()(int pm, int pn, Unit& u) const { u.aoff = pm * (4u * MB1); u.boff = pn * (4u * MB1); u.coff = 0; } };
struct MapAttQK { int sh, ld; __device__ __forceinline__ void operator()(int pm, int pn, Unit& u) const { u.aoff = (unsigned)(pm >> sh) * 4096u + ((unsigned)(pm & ((1 << sh) - 1)) * MB1 << ld); u.boff = pn * MB1; u.coff = (unsigned)pm * (256u * 2048u) + pn * 256u; } };
struct MapAttVT { int sh, ld; __device__ __forceinline__ void operator()(int pm, int pn, Unit& u) const { u.aoff = pm * MB1; u.boff = (unsigned)(pn >> sh) * 4096u + ((unsigned)(pn & ((1 << sh) - 1)) * MB1 << ld); u.coff = (unsigned)pm * (256u * 16384u) + pn * 256u; } };
struct MapOut1 { __device__ __forceinline__ void operator()(int pm, int pn, Unit& u) const { u.aoff = pm * MB1; u.boff = pn * MB1; u.coff = 0; } };

template <class Epi, class Map>
__device__ __forceinline__ void gemm_phase(LAS unsigned char* lds, const Gemm g, const Sched<Map>& S, const Epi& E) {
    int tid_ = threadIdx.x; asm volatile("" : "+v"(tid_));
    const int tid = tid_, wid = __builtin_amdgcn_readfirstlane(tid >> 6), lane = tid & 63, wr = wid >> 2, wc = wid & 3, fr = lane & 15, fq = lane >> 4;
    const int K = g.K, nt = K / BK;
    unsigned voffA[2], voffB[2];
#pragma unroll
    for (int i = 0; i < 2; ++i) { int R, C; stage_rc(tid * 16 + i * 8192, R, C); const int Rb = Epi::PERM ? ((R & ~31) + perm32(R & 31)) : R;
        voffA[i] = (unsigned)(R * g.lda + C) * 2u; voffB[i] = (unsigned)(Rb * g.ldb + C) * 2u; }
    const size_t kstep = (size_t)(BK * 2);
    const size_t hstepA = (size_t)HALF * g.lda * 2, hstepB = (size_t)HALF * g.ldb * 2;
    const unsigned ldsw = (unsigned)wid * 1024u;
    const int aoff = lds_byte(wr * 64 + fr, fq * 8), boff = lds_byte(wc * 32 + fr, fq * 8);
#define PG8_SA(b, h) (((b) * 2 + (h)) * HTB)
#define PG8_SB(b, h) ((4 + (b) * 2 + (h)) * HTB)
#define PG8_STAGE(bufoff, gbase, voff) do { _Pragma("unroll") for (int _i = 0; _i < 2; ++_i) \
        __builtin_amdgcn_global_load_lds((const unsigned*)((const char*)(gbase) + (voff)[_i]), (LAS unsigned*)(lds + (bufoff) + ldsw + _i * 8192), 16, 0, 0); } while (0)
#define PG8_LDA(dst, b, h) do { _Pragma("unroll") for (int m = 0; m < 4; ++m) _Pragma("unroll") for (int k = 0; k < 2; ++k) dst[m][k] = *(const LAS bf16x8*)(lds + PG8_SA(b, h) + aoff + m * 2048 + k * 1024); } while (0)
#define PG8_LDB(dst, b, h) do { _Pragma("unroll") for (int n = 0; n < 2; ++n) _Pragma("unroll") for (int k = 0; k < 2; ++k) dst[n][k] = *(const LAS bf16x8*)(lds + PG8_SB(b, h) + boff + n * 2048 + k * 1024); } while (0)
#define PG8_MMA(ai, bj, At, Bt) do { __builtin_amdgcn_s_setprio(1); _Pragma("unroll") for (int m = 0; m < 4; ++m) _Pragma("unroll") for (int n = 0; n < 2; ++n) _Pragma("unroll") for (int k = 0; k < 2; ++k) \
        acc[ai][bj][m][n] = __builtin_amdgcn_mfma_f32_16x16x32_bf16(Bt[n][k], At[m][k], acc[ai][bj][m][n], 0, 0, 0); __builtin_amdgcn_s_setprio(0); } while (0)
#define PG8_WAIT_V(n) asm volatile("s_waitcnt vmcnt(" #n ")" ::: "memory")
#define PG8_WAIT_L(n) asm volatile("s_waitcnt lgkmcnt(" #n ")" ::: "memory")
#define PG8_BAR __builtin_amdgcn_s_barrier()
#define PG8_SCHED __builtin_amdgcn_sched_barrier(0)
    Unit cur, nxt; int ui = 0;
    if (!S.next(0, cur)) return;
    f32x4 acc[2][2][4][2];
#pragma unroll
    for (int a = 0; a < 2; ++a)
#pragma unroll
        for (int b = 0; b < 2; ++b)
#pragma unroll
            for (int m = 0; m < 4; ++m)
#pragma unroll
                for (int n = 0; n < 2; ++n) acc[a][b][m][n] = (f32x4){0.f, 0.f, 0.f, 0.f};
    bf16x8 At[4][2], B0[2][2], B1[2][2];
    const char* cA = (const char*)g.A + cur.aoff; const char* cB = (const char*)g.Bt + cur.boff;
    PG8_STAGE(PG8_SB(0, 0), cB, voffB); PG8_STAGE(PG8_SB(0, 1), cB + hstepB, voffB); PG8_STAGE(PG8_SA(0, 0), cA, voffA); PG8_STAGE(PG8_SA(0, 1), cA + hstepA, voffA);
    if (wr == 1) PG8_BAR;
    PG8_WAIT_V(2); PG8_BAR;
    PG8_STAGE(PG8_SB(1, 0), cB + kstep, voffB); PG8_STAGE(PG8_SA(1, 0), cA + kstep, voffA); PG8_STAGE(PG8_SB(1, 1), cB + hstepB + kstep, voffB);
    PG8_WAIT_V(6); PG8_BAR;
#pragma unroll 1
    for (;;) {
        const bool has_next = S.next(ui + 1, nxt);
        const char* nA = has_next ? (const char*)g.A + nxt.aoff : cA; const char* nB = has_next ? (const char*)g.Bt + nxt.boff : cB;
#pragma unroll 1
        for (int t = 0; t < nt; t += 2) {
            const bool last = (t == nt - 2);
            const char* a1 = cA + (size_t)(t + 1) * kstep;
            const char* a2 = last ? nA : cA + (size_t)(t + 2) * kstep; const char* b2 = last ? nB : cB + (size_t)(t + 2) * kstep;
            const char* a3 = a2 + kstep; const char* b3 = b2 + kstep;
            PG8_LDB(B0, 0, 0); PG8_LDB(B1, 0, 1); PG8_SCHED; PG8_LDA(At, 0, 0); PG8_STAGE(PG8_SA(1, 1), a1 + hstepA, voffA);
            PG8_WAIT_V(8); PG8_WAIT_L(0); PG8_BAR; PG8_MMA(0, 0, At, B0); PG8_MMA(0, 1, At, B1); PG8_BAR; PG8_SCHED;
            PG8_LDA(At, 0, 1); PG8_STAGE(PG8_SB(0, 0), b2, voffB); PG8_STAGE(PG8_SB(0, 1), b2 + hstepB, voffB); PG8_STAGE(PG8_SA(0, 0), a2, voffA);
            PG8_WAIT_V(8); PG8_WAIT_L(0); PG8_BAR; PG8_MMA(1, 0, At, B0); PG8_MMA(1, 1, At, B1); PG8_BAR; PG8_SCHED;
            PG8_LDB(B0, 1, 0); PG8_LDB(B1, 1, 1); PG8_SCHED; PG8_LDA(At, 1, 0); PG8_STAGE(PG8_SA(0, 1), a2 + hstepA, voffA);
            PG8_WAIT_V(8); PG8_WAIT_L(0); PG8_BAR; PG8_MMA(0, 0, At, B0); PG8_MMA(0, 1, At, B1); PG8_BAR; PG8_SCHED;
            PG8_LDA(At, 1, 1); PG8_STAGE(PG8_SB(1, 0), b3, voffB); PG8_STAGE(PG8_SB(1, 1), b3 + hstepB, voffB); PG8_STAGE(PG8_SA(1, 0), a3, voffA);
            PG8_WAIT_V(8); PG8_WAIT_L(0); PG8_BAR; PG8_MMA(1, 0, At, B0); PG8_MMA(1, 1, At, B1); PG8_BAR; PG8_SCHED;
        }
        if (wr == 0) PG8_BAR;
        E(acc, cur, wr, wc, fr, fq);
        if (!has_next) break;
#pragma unroll
        for (int a = 0; a < 2; ++a)
#pragma unroll
            for (int b = 0; b < 2; ++b)
#pragma unroll
                for (int m = 0; m < 4; ++m)
#pragma unroll
                    for (int n = 0; n < 2; ++n) acc[a][b][m][n] = (f32x4){0.f, 0.f, 0.f, 0.f};
        cur = nxt; cA = nA; cB = nB; ++ui;
        if (wr == 1) PG8_BAR;
    }
    PG8_WAIT_V(0);
    PG8_BAR;
#undef PG8_SA
#undef PG8_SB
#undef PG8_STAGE
#undef PG8_LDA
#undef PG8_LDB
#undef PG8_MMA
#undef PG8_WAIT_V
#undef PG8_WAIT_L
#undef PG8_BAR
#undef PG8_SCHED
}

typedef f32x4 Acc[2][2][4][2];

template <int ACT> struct EpiBf16 {
    static constexpr bool PERM = true;
    bf16_t* O; int ldc;
    __device__ __forceinline__ void operator()(const Acc& acc, const Unit& u, int wr, int wc, int fr, int fq) const {
        asm volatile("" : "+v"(fr), "+v"(fq));
        bf16_t* base = O + u.coff + (size_t)(wr * 64 + fr) * ldc + wc * 32 + 8 * fq;
#pragma unroll
        for (int ai = 0; ai < 2; ++ai)
#pragma unroll
            for (int m = 0; m < 4; ++m) { bf16_t* rowp = base + (size_t)(ai * HALF + m * 16) * ldc;
#pragma unroll
                for (int bj = 0; bj < 2; ++bj) { f32x4 v0 = acc[ai][bj][m][0], v1 = acc[ai][bj][m][1];
                    if (ACT == 1) {
#pragma unroll
                        for (int j = 0; j < 4; ++j) { v0[j] = silu_f(v0[j]); v1[j] = silu_f(v1[j]); } }
                    if (ACT == 2) {
#pragma unroll
                        for (int j = 0; j < 4; ++j) { const float a = fmaxf(v0[j], 0.f), b = fmaxf(v1[j], 0.f); v0[j] = a * a; v1[j] = b * b; } }
                    u32x4 w; w.x = cvt_pk_bf16(v0[0], v0[1]); w.y = cvt_pk_bf16(v0[2], v0[3]); w.z = cvt_pk_bf16(v1[0], v1[1]); w.w = cvt_pk_bf16(v1[2], v1[3]);
                    *(u32x4*)(rowp + bj * HALF) = w; } }
    }
};
struct EpiRes {
    static constexpr bool PERM = false;
    const float* base; float* out; const float* gate; int gate_bstride;
    __device__ __forceinline__ void operator()(const Acc& acc, const Unit& u, int wr, int wc, int fr, int fq) const {
        asm volatile("" : "+v"(fr), "+v"(fq));
        const int row0 = u.pm * BM + wr * 64 + fr, col0 = u.pn * BM + wc * 32 + 4 * fq;
        const float* gp = gate + (size_t)(u.pm >> 6) * gate_bstride + col0;
        f32x4 gv[2][2];
#pragma unroll
        for (int bj = 0; bj < 2; ++bj)
#pragma unroll
            for (int n = 0; n < 2; ++n) gv[bj][n] = *(const f32x4*)(gp + bj * HALF + n * 16);
#pragma unroll
        for (int aim = 0; aim < 4; ++aim) { const int ai = aim >> 1, m0 = (aim & 1) * 2;
            f32x4 bs[2][2][2];
#pragma unroll
            for (int mm = 0; mm < 2; ++mm) { const size_t off = (size_t)(row0 + ai * HALF + (m0 + mm) * 16) * D + col0;
#pragma unroll
                for (int bj = 0; bj < 2; ++bj)
#pragma unroll
                    for (int n = 0; n < 2; ++n) bs[mm][bj][n] = *(const f32x4*)(base + off + bj * HALF + n * 16); }
#pragma unroll
            for (int mm = 0; mm < 2; ++mm) { const size_t off = (size_t)(row0 + ai * HALF + (m0 + mm) * 16) * D + col0;
#pragma unroll
                for (int bj = 0; bj < 2; ++bj)
#pragma unroll
                    for (int n = 0; n < 2; ++n) *(f32x4*)(out + off + bj * HALF + n * 16) = bs[mm][bj][n] + gv[bj][n] * acc[ai][bj][m0 + mm][n]; }
            asm volatile("" ::: "memory"); }
    }
};
struct EpiY {
    static constexpr bool PERM = true;
    bf16_t* Y; const float* gate; int gate_bstride;
    __device__ __forceinline__ void operator()(const Acc& acc, const Unit& u, int wr, int wc, int fr, int fq) const {
        asm volatile("" : "+v"(fr), "+v"(fq));
        const int col0 = u.pn * BM + wc * 32 + 8 * fq;
        const float* gp = gate + (size_t)(u.pm >> 6) * gate_bstride + col0;
        f32x4 gv[2][2];
#pragma unroll
        for (int bj = 0; bj < 2; ++bj) { gv[bj][0] = *(const f32x4*)(gp + bj * HALF); gv[bj][1] = *(const f32x4*)(gp + bj * HALF + 4); }
        bf16_t* base = Y + (size_t)(u.pm * BM + wr * 64 + fr) * D + col0;
#pragma unroll
        for (int ai = 0; ai < 2; ++ai)
#pragma unroll
            for (int m = 0; m < 4; ++m) { bf16_t* rowp = base + (size_t)(ai * HALF + m * 16) * D;
#pragma unroll
                for (int bj = 0; bj < 2; ++bj) { const f32x4 v0 = acc[ai][bj][m][0] * gv[bj][0], v1 = acc[ai][bj][m][1] * gv[bj][1];
                    u32x4 w; w.x = cvt_pk_bf16(v0[0], v0[1]); w.y = cvt_pk_bf16(v0[2], v0[3]); w.z = cvt_pk_bf16(v1[0], v1[1]); w.w = cvt_pk_bf16(v1[2], v1[3]);
                    *(u32x4*)(rowp + bj * HALF) = w; } }
    }
};
struct EpiRetQK {
    static constexpr bool PERM = true;
    bf16_t* O; int ldc; const f32x4* cs;   int mode;   const float* l2g; bf16_t* KZ;
    __device__ __forceinline__ void operator()(const Acc& acc, const Unit& u, int wr, int wc, int fr, int fq) const {
        asm volatile("" : "+v"(fr), "+v"(fq));
        const float lg = l2g[u.pn];
#pragma unroll
        for (int ai = 0; ai < 2; ++ai)
#pragma unroll
            for (int m = 0; m < 4; ++m) {
                const int row_in = ai * HALF + wr * 64 + m * 16 + fr, s = u.pm * BM + row_in;
                const float rs = mode == 0 ? exp2f((float)(row_in + 1) * lg) : 0.0625f;
                const f32x4* cp = cs + ((size_t)s * 128 + wc * 32 + 8 * fq) / 2;
                f32x4 t[4];
#pragma unroll
                for (int i = 0; i < 4; ++i) t[i] = cp[i];
                float o1[8], o2[8];
#pragma unroll
                for (int n = 0; n < 2; ++n)
#pragma unroll
                    for (int j = 0; j < 4; ++j) { const int e = n * 4 + j; const float co = t[e >> 1][(e & 1) * 2], si = t[e >> 1][(e & 1) * 2 + 1];
                        const float x1 = acc[ai][0][m][n][j], x2 = acc[ai][1][m][n][j];
                        o1[e] = (x1 * co - x2 * si) * rs; o2[e] = (x2 * co + x1 * si) * rs; }
                bf16_t* rowp = O + u.coff + (size_t)row_in * ldc + wc * 32 + 8 * fq;
                u32x4 w; w.x = cvt_pk_bf16(o1[0], o1[1]); w.y = cvt_pk_bf16(o1[2], o1[3]); w.z = cvt_pk_bf16(o1[4], o1[5]); w.w = cvt_pk_bf16(o1[6], o1[7]);
                *(u32x4*)rowp = w;
                w.x = cvt_pk_bf16(o2[0], o2[1]); w.y = cvt_pk_bf16(o2[2], o2[3]); w.z = cvt_pk_bf16(o2[4], o2[5]); w.w = cvt_pk_bf16(o2[6], o2[7]);
                *(u32x4*)(rowp + HALF) = w;
                if (mode == 1) {
                    const float z = exp2f((float)(255 - row_in) * lg);
                    bf16_t* kz = KZ + u.coff + (size_t)(wc * 32 + 8 * fq) * 256 + row_in;
#pragma unroll
                    for (int e = 0; e < 8; e += 2) { const unsigned p1 = cvt_pk_bf16(o1[e] * z, o1[e + 1] * z), p2 = cvt_pk_bf16(o2[e] * z, o2[e + 1] * z);
                        kz[(size_t)e * 256] = (bf16_t)(p1 & 0xffffu); kz[(size_t)(e + 1) * 256] = (bf16_t)(p1 >> 16);
                        kz[(size_t)(e + HALF) * 256] = (bf16_t)(p2 & 0xffffu); kz[(size_t)(e + 1 + HALF) * 256] = (bf16_t)(p2 >> 16); }
                }
            }
    }
};
struct EpiKzT {
    static constexpr bool PERM = true;
    bf16_t* O; const f32x4* csT;   const float* l2g;
    __device__ __forceinline__ void operator()(const Acc& acc, const Unit& u, int wr, int wc, int fr, int fq) const {
        asm volatile("" : "+v"(fr), "+v"(fq));
        const float lg = l2g[u.pm];
#pragma unroll
        for (int bj = 0; bj < 2; ++bj) {
            const int tok0 = bj * HALF + wc * 32 + 8 * fq;
            float zs[8];
#pragma unroll
            for (int e = 0; e < 8; ++e) zs[e] = 0.0625f * exp2f((float)(255 - (tok0 + e)) * lg);
#pragma unroll
            for (int m = 0; m < 4; ++m) {
                const int d = wr * 64 + m * 16 + fr;
                const f32x4* cp = csT + ((size_t)d * SEQ + u.pn * BM + tok0) / 2;
                f32x4 t[4];
#pragma unroll
                for (int i = 0; i < 4; ++i) t[i] = cp[i];
                float o1[8], o2[8];
#pragma unroll
                for (int n = 0; n < 2; ++n)
#pragma unroll
                    for (int j = 0; j < 4; ++j) { const int e = n * 4 + j; const float co = t[e >> 1][(e & 1) * 2], si = t[e >> 1][(e & 1) * 2 + 1];
                        const float x1 = acc[0][bj][m][n][j], x2 = acc[1][bj][m][n][j];
                        o1[e] = (x1 * co - x2 * si) * zs[e]; o2[e] = (x2 * co + x1 * si) * zs[e]; }
                bf16_t* rowp = O + u.coff + (size_t)d * 256 + tok0;
                u32x4 w; w.x = cvt_pk_bf16(o1[0], o1[1]); w.y = cvt_pk_bf16(o1[2], o1[3]); w.z = cvt_pk_bf16(o1[4], o1[5]); w.w = cvt_pk_bf16(o1[6], o1[7]);
                *(u32x4*)rowp = w;
                w.x = cvt_pk_bf16(o2[0], o2[1]); w.y = cvt_pk_bf16(o2[2], o2[3]); w.z = cvt_pk_bf16(o2[4], o2[5]); w.w = cvt_pk_bf16(o2[6], o2[7]);
                *(u32x4*)(rowp + (size_t)HALF * 256) = w;
            }
        }
    }
};
struct EpiP {
    static constexpr bool PERM = true;
    bf16_t* O; const float* l2g;
    __device__ __forceinline__ void operator()(const Acc& acc, const Unit& u, int wr, int wc, int fr, int fq) const {
        asm volatile("" : "+v"(fr), "+v"(fq));
        const float lg = l2g[u.pm >> 6];
#pragma unroll
        for (int bj = 0; bj < 2; ++bj) {
            const int j0 = bj * HALF + wc * 32 + 8 * fq;
            float f[8];
#pragma unroll
            for (int e = 0; e < 8; ++e) f[e] = exp2f(-(float)(j0 + e + 1) * lg);
#pragma unroll
            for (int ai = 0; ai < 2; ++ai)
#pragma unroll
                for (int m = 0; m < 4; ++m) {
                    const int i = ai * HALF + wr * 64 + m * 16 + fr;
                    float o[8];
#pragma unroll
                    for (int n = 0; n < 2; ++n)
#pragma unroll
                        for (int j = 0; j < 4; ++j) { const int e = n * 4 + j; o[e] = (i >= j0 + e) ? acc[ai][bj][m][n][j] * f[e] : 0.f; }
                    u32x4 w; w.x = cvt_pk_bf16(o[0], o[1]); w.y = cvt_pk_bf16(o[2], o[3]); w.z = cvt_pk_bf16(o[4], o[5]); w.w = cvt_pk_bf16(o[6], o[7]);
                    *(u32x4*)(O + u.coff + (size_t)i * 512 + j0) = w;
                }
        }
    }
};
struct EpiO {
    static constexpr bool PERM = true;
    bf16_t* O; f32x2* stats;
    __device__ __forceinline__ void operator()(const Acc& acc, const Unit& u, int wr, int wc, int fr, int fq) const {
        asm volatile("" : "+v"(fr), "+v"(fq));
        const int h = u.pm >> 6, nchunk = u.pm & 63, et = u.pn;
#pragma unroll
        for (int ai = 0; ai < 2; ++ai)
#pragma unroll
            for (int m = 0; m < 4; ++m) {
                const int row_in = ai * HALF + wr * 64 + m * 16 + fr;
                float s1 = 0.f, s2 = 0.f;
#pragma unroll
                for (int bj = 0; bj < 2; ++bj) {
                    const f32x4 v0 = acc[ai][bj][m][0], v1 = acc[ai][bj][m][1];
#pragma unroll
                    for (int j = 0; j < 4; ++j) { s1 += v0[j] + v1[j]; s2 += v0[j] * v0[j] + v1[j] * v1[j]; }
                    u32x4 w; w.x = cvt_pk_bf16(v0[0], v0[1]); w.y = cvt_pk_bf16(v0[2], v0[3]); w.z = cvt_pk_bf16(v1[0], v1[1]); w.w = cvt_pk_bf16(v1[2], v1[3]);
                    *(u32x4*)(O + u.coff + (size_t)row_in * RV + bj * HALF + wc * 32 + 8 * fq) = w;
                }
                s1 += __shfl_xor(s1, 16); s1 += __shfl_xor(s1, 32); s2 += __shfl_xor(s2, 16); s2 += __shfl_xor(s2, 32);
                if (fq == 0) stats[((size_t)(nchunk * 256 + row_in) * 8 + h) * 8 + et * 4 + wc] = (f32x2){s1, s2};
            }
    }
};
struct EpiGate {
    static constexpr bool PERM = true;
    bf16_t* U; const bf16_t* O; const f32x2* stats;
    __device__ __forceinline__ void operator()(const Acc& acc, const Unit& u, int wr, int wc, int fr, int fq) const {
        asm volatile("" : "+v"(fr), "+v"(fq));
        const int h = u.pn >> 1;
#pragma unroll
        for (int ai = 0; ai < 2; ++ai)
#pragma unroll
            for (int m = 0; m < 4; ++m) {
                const int row_in = ai * HALF + wr * 64 + m * 16 + fr, s = u.pm * BM + row_in;
                const f32x4 tq = ((const f32x4*)(stats + ((size_t)s * 8 + h) * 8))[fq];
                const size_t off = (size_t)s * RV + u.pn * BM + wc * 32 + 8 * fq;
                const u32x4 o0 = *(const u32x4*)(O + off), o1 = *(const u32x4*)(O + off + HALF);
                float s1 = tq[0] + tq[2], s2 = tq[1] + tq[3];
                { const auto r1 = __builtin_amdgcn_permlane16_swap(__float_as_uint(s1), __float_as_uint(s1), false, false); s1 = __uint_as_float(r1[0]) + __uint_as_float(r1[1]);
                  const auto r2 = __builtin_amdgcn_permlane16_swap(__float_as_uint(s2), __float_as_uint(s2), false, false); s2 = __uint_as_float(r2[0]) + __uint_as_float(r2[1]);
                  const auto r3 = __builtin_amdgcn_permlane32_swap(__float_as_uint(s1), __float_as_uint(s1), false, false); s1 = __uint_as_float(r3[0]) + __uint_as_float(r3[1]);
                  const auto r4 = __builtin_amdgcn_permlane32_swap(__float_as_uint(s2), __float_as_uint(s2), false, false); s2 = __uint_as_float(r4[0]) + __uint_as_float(r4[1]); }
                const float mu = s1 * (1.0f / 512.0f), var = fmaxf(s2 * (1.0f / 512.0f) - mu * mu, 0.f), rstd = rsqrtf(var + EPS);
#pragma unroll
                for (int bj = 0; bj < 2; ++bj) { const u32x4 ov = bj == 0 ? o0 : o1; const unsigned ow[4] = {ov.x, ov.y, ov.z, ov.w}; unsigned r[4];
#pragma unroll
                    for (int p = 0; p < 4; ++p) { const f32x4 v = acc[ai][bj][m][p >> 1]; const float g0 = silu_f(v[(p & 1) * 2]), g1 = silu_f(v[(p & 1) * 2 + 1]);
                        r[p] = cvt_pk_bf16(g0 * ((bf_lo(ow[p]) - mu) * rstd), g1 * ((bf_hi(ow[p]) - mu) * rstd)); }
                    *(u32x4*)(U + off + bj * HALF) = (u32x4){r[0], r[1], r[2], r[3]}; }
            }
    }
};
struct EpiAttQK {
    static constexpr bool PERM = false;
    bf16_t* O; const f32x4* csa;   int ld, lL;
    __device__ __forceinline__ void operator()(const Acc& acc, const Unit& u, int wr, int wc, int fr, int fq) const {
        asm volatile("" : "+v"(fr), "+v"(fq));
#pragma unroll
        for (int ai = 0; ai < 2; ++ai)
#pragma unroll
            for (int m = 0; m < 4; ++m) {
                const int row_in = ai * HALF + wr * 64 + m * 16 + fr, c = u.pm * BM + row_in;
                const int tok = ((c & ((1 << lL) - 1)) << ld) + (c >> lL);
                f32x4 t0 = (f32x4){1.f, 0.f, 1.f, 0.f}, t1 = t0;
                if (wc == 0) { const f32x4* cp = csa + ((size_t)tok * 16 + 4 * fq) / 2; t0 = cp[0]; t1 = cp[1]; }
                bf16_t* rowp = O + u.coff + (size_t)row_in * D + wc * 32 + ((fq & 1) ? 16 + 4 * (fq - 1) : 4 * fq);
#pragma unroll
                for (int bj = 0; bj < 2; ++bj) {
                    const f32x4 x1 = acc[ai][bj][m][0], x2 = acc[ai][bj][m][1];
                    float o1[4], o2[4];
                    const float cc[4] = {t0[0], t0[2], t1[0], t1[2]}, ss[4] = {t0[1], t0[3], t1[1], t1[3]};
#pragma unroll
                    for (int j = 0; j < 4; ++j) { o1[j] = x1[j] * cc[j] - x2[j] * ss[j]; o2[j] = x2[j] * cc[j] + x1[j] * ss[j]; }
                    const unsigned lo0 = cvt_pk_bf16(o1[0], o1[1]), lo1 = cvt_pk_bf16(o1[2], o1[3]), hi0 = cvt_pk_bf16(o2[0], o2[1]), hi1 = cvt_pk_bf16(o2[2], o2[3]);
                    const auto s0 = __builtin_amdgcn_permlane16_swap(lo0, hi0, false, false), s1 = __builtin_amdgcn_permlane16_swap(lo1, hi1, false, false);
                    *(u32x4*)(rowp + bj * HALF) = (u32x4){s0[0], s1[0], s0[1], s1[1]};
                }
            }
    }
};
}

struct Ctx { int tid, lane, wave, G, vcu, gw, ngw; LAS unsigned char* lds; };

__device__ __forceinline__ void transpose_items(const Ctx& X, const float* W, int K, int N, bf16_t* Wt, int& base_item) {
    const int nk = K / 64, nn = N / 64, nitems = nk * nn;
    LAS unsigned* scr = (LAS unsigned*)(X.lds + X.wave * 8448);
    int first = (X.gw - base_item % X.ngw + X.ngw) % X.ngw;
    const int kk = X.lane >> 4, n4 = (X.lane & 15) * 4;
    f32x4 ra[8], rb[8];
    if (first < nitems) { const int kt = first % nk, ntile = first / nk; const float* src = W + (size_t)(kt * 64 + 2 * kk) * N + ntile * 64 + n4;
#pragma unroll
        for (int i = 0; i < 8; ++i) { ra[i] = *(const f32x4*)(src + (size_t)(8 * i) * N); rb[i] = *(const f32x4*)(src + (size_t)(8 * i + 1) * N); } }
#pragma unroll 1
    for (int it = first; it < nitems; it += X.ngw) {
        const int kt = it % nk, ntile = it / nk;
#pragma unroll
        for (int i = 0; i < 8; ++i)
#pragma unroll
            for (int j = 0; j < 4; ++j) scr[(n4 + j) * 33 + kk + 4 * i] = cvt_pk_bf16(ra[i][j], rb[i][j]);
        if (it + X.ngw < nitems) { const int it2 = it + X.ngw, kt2 = it2 % nk, nt2 = it2 / nk; const float* src = W + (size_t)(kt2 * 64 + 2 * kk) * N + nt2 * 64 + n4;
#pragma unroll
            for (int i = 0; i < 8; ++i) { ra[i] = *(const f32x4*)(src + (size_t)(8 * i) * N); rb[i] = *(const f32x4*)(src + (size_t)(8 * i + 1) * N); } }
        __builtin_amdgcn_wave_barrier();
        asm volatile("s_waitcnt lgkmcnt(0)" ::: "memory");
#pragma unroll
        for (int r0 = 0; r0 < 64; r0 += 8) { const int r = r0 + (X.lane >> 3), seg = X.lane & 7;
            u32x4 w; w.x = scr[r * 33 + seg * 4 + 0]; w.y = scr[r * 33 + seg * 4 + 1]; w.z = scr[r * 33 + seg * 4 + 2]; w.w = scr[r * 33 + seg * 4 + 3];
            *(u32x4*)(Wt + (size_t)(ntile * 64 + r) * K + kt * 64 + seg * 8) = w; }
        asm volatile("s_waitcnt lgkmcnt(0)" ::: "memory");
        __builtin_amdgcn_wave_barrier();
    }
    base_item += nitems;
}

__device__ __forceinline__ void sincos_d(float angf, float& co, float& si) {
    const double a = (double)angf;
    const double n = rint(a * 0.63661977236758134308);
    double r = fma(-n, 1.57079632679489655800, a); r = fma(-n, 6.12323399573676603587e-17, r);
    const double r2 = r * r;
    double sp = -1.0 / 6227020800.0; sp = fma(sp, r2, 1.0 / 39916800.0); sp = fma(sp, r2, -1.0 / 362880.0); sp = fma(sp, r2, 1.0 / 5040.0); sp = fma(sp, r2, -1.0 / 120.0); sp = fma(sp, r2, 1.0 / 6.0);
    sp = fma(-sp * r2, r, r);
    double cp = 1.0 / 479001600.0; cp = fma(cp, r2, -1.0 / 3628800.0); cp = fma(cp, r2, 1.0 / 40320.0); cp = fma(cp, r2, -1.0 / 720.0); cp = fma(cp, r2, 1.0 / 24.0); cp = fma(cp, r2, -0.5); cp = fma(cp, r2, 1.0);
    const int q = ((int)(long long)n) & 3;
    const double s_ = (q & 1) ? cp : sp, c_ = (q & 1) ? sp : cp;
    si = (float)((q & 2) ? -s_ : s_); co = (float)(((q + 1) & 2) ? -c_ : c_);
}

__device__ __forceinline__ void tables_phase(const Ctx& X, const Args& a) {
    LAS float* tab = (LAS float*)(X.lds + 131072);
    f32x2* csr = (f32x2*)(a.ws + WS_CSR); f32x2* csa = (f32x2*)(a.ws + WS_CSA);
    const int gt = blockIdx.x * NT + X.tid, ngt = X.G * NT;
    for (int i = gt; i < NB * SEQ * 128; i += ngt) { const int d = i & 127, bs = i >> 7;
        const float ang = (float)a.pos[bs] * tab[d]; float co, si; sincos_d(ang, co, si);
        csr[i] = (f32x2){co, si}; }
    for (int i = gt; i < NB * SEQ * 16; i += ngt) { const int d = i & 15, bs = i >> 4;
        const float ang = (float)a.pos[bs] * tab[128 + d]; float co, si; sincos_d(ang, co, si); csa[i] = (f32x2){co, si}; }
}

__device__ __forceinline__ void modp_phase(const Ctx& X, const Args& a) {
    float* modp = (float*)(a.ws + WS_MODP);
    LAS float* red = (LAS float*)X.lds;
    const int nq = X.tid & 127, ks = X.tid >> 7;
    for (int it = blockIdx.x; it < 2 * 24 * 16; it += X.G) {
        const int layer = it / 384, r = it % 384, nch = r / 16, sl = r % 16;
        const int k0 = sl * 128 + ks * 32, n0 = nch * 512 + nq * 4;
        const float* wp = a.ada_w + ((size_t)layer * D + k0) * 12288 + n0;
        f32x4 acc0 = (f32x4){0.f, 0.f, 0.f, 0.f}, acc1 = acc0;
#pragma unroll 8
        for (int k = 0; k < 32; ++k) { const f32x4 w = *(const f32x4*)(wp + (size_t)k * 12288);
            const float c0 = silu_f(a.c[k0 + k]), c1 = silu_f(a.c[D + k0 + k]); acc0 += w * c0; acc1 += w * c1; }
        __syncthreads();
        *(LAS f32x4*)(red + (ks * 2 + 0) * 512 + nq * 4) = acc0; *(LAS f32x4*)(red + (ks * 2 + 1) * 512 + nq * 4) = acc1;
        __syncthreads();
        for (int o = X.tid; o < 1024; o += NT) { const int b = o >> 9, col = o & 511;
            const float v = red[(0 * 2 + b) * 512 + col] + red[(1 * 2 + b) * 512 + col] + red[(2 * 2 + b) * 512 + col] + red[(3 * 2 + b) * 512 + col];
            modp[(((size_t)sl * 2 + layer) * 2 + b) * 12288 + nch * 512 + col] = v; }
    }
    __syncthreads();
}
__device__ __forceinline__ void modfin_phase(const Ctx& X, const Args& a) {
    const float* modp = (const float*)(a.ws + WS_MODP); float* mod = (float*)(a.ws + WS_MOD);
    for (int i = blockIdx.x * NT + X.tid; i < 4 * 12288; i += X.G * NT) { const int layer = i / (2 * 12288), n = i % 12288;
        float v = a.ada_b[layer * 12288 + n];
#pragma unroll
        for (int s = 0; s < 16; ++s) v += modp[(size_t)s * 4 * 12288 + i];
        mod[i] = v; }
}

__device__ __forceinline__ void norm_mod_phase(const Ctx& X, const float* xin, const float* gain, const float* mod_layer, int which_shift, bf16_t* h, int r0, int r1) {
    int bcur = -1; float PA[32], PB[32];
#pragma unroll
    for (int i = 0; i < 32; ++i) { PA[i] = 0.f; PB[i] = 0.f; }
    for (int row0 = r0 + X.gw; row0 < r1; row0 += 2 * X.ngw) {
        f32x4 v[2][8]; float ss[2] = {0.f, 0.f};
#pragma unroll
        for (int r = 0; r < 2; ++r) { const int row = row0 + r * X.ngw; if (row < r1) { const float* xp = xin + (size_t)row * D;
#pragma unroll
            for (int j = 0; j < 4; ++j) { v[r][2 * j] = *(const f32x4*)(xp + 8 * (X.lane + 64 * j)); v[r][2 * j + 1] = *(const f32x4*)(xp + 8 * (X.lane + 64 * j) + 4); } } }
#pragma unroll
        for (int r = 0; r < 2; ++r) { const int row = row0 + r * X.ngw; if (row < r1) {
            const int b = row / SEQ;
            if (b != bcur) { bcur = b; const float* sh = mod_layer + (size_t)b * 12288 + which_shift * D; const float* sc = sh + D;
#pragma unroll
                for (int j = 0; j < 4; ++j) { const int col = 8 * (X.lane + 64 * j);
#pragma unroll
                    for (int e = 0; e < 8; ++e) { PA[8 * j + e] = gain[col + e] * (1.0f + sc[col + e]); PB[8 * j + e] = sh[col + e]; } } }
#pragma unroll
            for (int j = 0; j < 8; ++j) ss[r] += v[r][j][0] * v[r][j][0] + v[r][j][1] * v[r][j][1] + v[r][j][2] * v[r][j][2] + v[r][j][3] * v[r][j][3];
            ss[r] = wave_sum(ss[r]); const float rstd = rsqrtf(ss[r] * (1.0f / D) + EPS);
#pragma unroll
            for (int j = 0; j < 4; ++j) { const int col = 8 * (X.lane + 64 * j); float o[8];
#pragma unroll
                for (int e = 0; e < 8; ++e) o[e] = (v[r][2 * j + (e >> 2)][e & 3] * rstd) * PA[8 * j + e] + PB[8 * j + e];
                u32x4 w; w.x = cvt_pk_bf16(o[0], o[1]); w.y = cvt_pk_bf16(o[2], o[3]); w.z = cvt_pk_bf16(o[4], o[5]); w.w = cvt_pk_bf16(o[6], o[7]);
                *(u32x4*)(h + (size_t)row * D + col) = w; } } }
    }
}
__device__ __forceinline__ void final_norm_phase(const Ctx& X, float* xio, const bf16_t* y, const float* gain) {
    for (int row0 = X.gw; row0 < T; row0 += 2 * X.ngw) {
        f32x4 v[2][8];
#pragma unroll
        for (int r = 0; r < 2; ++r) { const int row = row0 + r * X.ngw; if (row < T) { const float* xp = xio + (size_t)row * D; const bf16_t* yp = y + (size_t)row * D;
#pragma unroll
            for (int j = 0; j < 4; ++j) { const int col = 8 * (X.lane + 64 * j); const u32x4 yy = *(const u32x4*)(yp + col);
                v[r][2 * j] = *(const f32x4*)(xp + col) + (f32x4){bf_lo(yy.x), bf_hi(yy.x), bf_lo(yy.y), bf_hi(yy.y)};
                v[r][2 * j + 1] = *(const f32x4*)(xp + col + 4) + (f32x4){bf_lo(yy.z), bf_hi(yy.z), bf_lo(yy.w), bf_hi(yy.w)}; } } }
#pragma unroll
        for (int r = 0; r < 2; ++r) { const int row = row0 + r * X.ngw; if (row < T) { float* xp = xio + (size_t)row * D; float ss = 0.f;
#pragma unroll
            for (int j = 0; j < 8; ++j) ss += v[r][j][0] * v[r][j][0] + v[r][j][1] * v[r][j][1] + v[r][j][2] * v[r][j][2] + v[r][j][3] * v[r][j][3];
            ss = wave_sum(ss); const float rstd = rsqrtf(ss * (1.0f / D) + EPS);
#pragma unroll
            for (int j = 0; j < 4; ++j) { const int col = 8 * (X.lane + 64 * j); const f32x4 g0 = *(const f32x4*)(gain + col), g1 = *(const f32x4*)(gain + col + 4);
                *(f32x4*)(xp + col) = v[r][2 * j] * rstd * g0; *(f32x4*)(xp + col + 4) = v[r][2 * j + 1] * rstd * g1; } } }
    }
}

__device__ __forceinline__ void scan_phase(const Ctx& X, bf16_t* BP, const float* l2g) {
    const int gt = blockIdx.x * NT + X.tid;
    for (int i = gt; i < 8 * 512 * 32; i += X.G * NT) {
        const int dg = i & 31, e = (i >> 5) & 511, h = i >> 14;
        const float cd = exp2f(256.0f * l2g[h]);
        bf16_t* p = BP + ((size_t)h * 64 * 512 + e) * 512 + dg * 8;
        float carry[8];
#pragma unroll
        for (int j = 0; j < 8; ++j) carry[j] = 0.f;
#pragma unroll 8
        for (int n = 0; n < 64; ++n) { bf16_t* q = p + (size_t)n * 512 * 512; const u32x4 uu = *(const u32x4*)q;
            u32x4 w; w.x = cvt_pk_bf16(carry[0], carry[1]); w.y = cvt_pk_bf16(carry[2], carry[3]); w.z = cvt_pk_bf16(carry[4], carry[5]); w.w = cvt_pk_bf16(carry[6], carry[7]);
            *(u32x4*)q = w;
            carry[0] = carry[0] * cd + bf_lo(uu.x); carry[1] = carry[1] * cd + bf_hi(uu.x); carry[2] = carry[2] * cd + bf_lo(uu.y); carry[3] = carry[3] * cd + bf_hi(uu.y);
            carry[4] = carry[4] * cd + bf_lo(uu.z); carry[5] = carry[5] * cd + bf_hi(uu.z); carry[6] = carry[6] * cd + bf_lo(uu.w); carry[7] = carry[7] * cd + bf_hi(uu.w); }
    }
}

__device__ __forceinline__ void normgate_phase(const Ctx& X, const bf16_t* O, bf16_t* GG, const f32x2* stats) {
    const int col = X.tid * 8, h = X.tid >> 6;
    for (int s0 = blockIdx.x * 4; s0 < SEQ; s0 += X.G * 4) {
        u32x4 ov[4], gv[4]; f32x4 stv[4][4];
#pragma unroll
        for (int r = 0; r < 4; ++r) { const int s = s0 + r; ov[r] = *(const u32x4*)(O + (size_t)s * RV + col); gv[r] = *(const u32x4*)(GG + (size_t)s * RV + col);
            const f32x4* st = (const f32x4*)(stats + ((size_t)s * 8 + h) * 8);
#pragma unroll
            for (int j = 0; j < 4; ++j) stv[r][j] = st[j]; }
#pragma unroll
        for (int r = 0; r < 4; ++r) { const int s = s0 + r; float s1 = 0.f, s2 = 0.f;
#pragma unroll
            for (int j = 0; j < 4; ++j) { s1 += stv[r][j][0] + stv[r][j][2]; s2 += stv[r][j][1] + stv[r][j][3]; }
            const float mu = s1 * (1.0f / 512.0f), var = fmaxf(s2 * (1.0f / 512.0f) - mu * mu, 0.f), rstd = rsqrtf(var + EPS);
            const unsigned ow[4] = {ov[r].x, ov[r].y, ov[r].z, ov[r].w}, gw[4] = {gv[r].x, gv[r].y, gv[r].z, gv[r].w}; unsigned rr[4];
#pragma unroll
            for (int j = 0; j < 4; ++j) { const float a0 = bf_lo(gw[j]) * ((bf_lo(ow[j]) - mu) * rstd), a1 = bf_hi(gw[j]) * ((bf_hi(ow[j]) - mu) * rstd); rr[j] = cvt_pk_bf16(a0, a1); }
            *(u32x4*)(GG + (size_t)s * RV + col) = (u32x4){rr[0], rr[1], rr[2], rr[3]}; }
    }
}

constexpr int KP = 272, VP = 528, LDS_V = 256 * KP;
__device__ __forceinline__ void attn_load_block(const bf16_t* ACT, int g, int hh, int bl, int cbq, int tid, u32x4 (&kreg)[4], u32x4 (&vreg)[4], bf16x8 (&qf)[4], bool want_q) {
    const bf16_t* Kg = ACT + (size_t)(g * 3 + 1) * SEQ * D; const bf16_t* VTg = ACT + (size_t)(g * 3 + 2) * SEQ * D;
    if (want_q) { const int lane = tid & 63, w = tid >> 6, n = lane & 15, q = lane >> 4; const bf16_t* qrow = ACT + (size_t)(g * 3) * SEQ * D + (size_t)(cbq * 128 + 16 * w + n) * D + hh * 128;
#pragma unroll
      for (int ks = 0; ks < 4; ++ks) qf[ks] = *(const bf16x8*)(qrow + 32 * ks + 8 * q); }
    const int row = tid >> 4, seg = tid & 15;
#pragma unroll
    for (int it = 0; it < 4; ++it) kreg[it] = *(const u32x4*)(Kg + (size_t)(bl * 128 + row + 32 * it) * D + hh * 128 + seg * 8);
#pragma unroll
    for (int it = 0; it < 4; ++it) vreg[it] = *(const u32x4*)(VTg + (size_t)(hh * 128 + row + 32 * it) * SEQ + bl * 128 + seg * 8);
}
__device__ __forceinline__ void attn_phase(const Ctx& X, bf16_t* ACT, float* LSE, bf16_t* Hb, const int g_lo, const int g_hi, const bool fuse) {
    const int tid = X.tid, lane = X.lane, w = X.wave, n = lane & 15, q = lane >> 4;
    const int nruns = (g_hi - g_lo) * 16 * 16;
    u32x4 kreg[4], vreg[4]; bf16x8 qn[4];
    const int lrow = tid >> 4, lseg = tid & 15;
#pragma unroll 1
    for (int run = X.vcu; run < nruns; run += X.G) {
        const int g = g_lo + (run >> 8), hh = (run >> 4) & 15, cb0 = (run & 15) * 8; const int nb = 128 >> (2 * g);
        attn_load_block(ACT, g, hh, cb0 > 0 ? cb0 - 1 : 0, 0, tid, kreg, vreg, qn, false);
#pragma unroll 1
        for (int step = 0; step < 9; ++step) {
            const int bl = cb0 - 1 + step, slot = bl & 1;
#pragma unroll
            for (int it = 0; it < 4; ++it) *(LAS u32x4*)(X.lds + (slot * 128 + lrow + 32 * it) * KP + lseg * 16) = kreg[it];
#pragma unroll
            for (int it = 0; it < 4; ++it) *(LAS u32x4*)(X.lds + LDS_V + (lrow + 32 * it) * VP + slot * 256 + lseg * 16) = vreg[it];
            __syncthreads();
            bf16x8 qf[4];
#pragma unroll
            for (int ks = 0; ks < 4; ++ks) qf[ks] = qn[ks];
            if (step < 8) attn_load_block(ACT, g, hh, cb0 + step, cb0 + step, tid, kreg, vreg, qn, true);
            if (step >= 1) {
                const int cb = cb0 + step - 1; const bool hp = (cb & (nb - 1)) != 0; const int par = (cb + 1) & 1;
                bf16_t* qrow = ACT + (size_t)(g * 3) * SEQ * D + (size_t)(cb * 128 + 16 * w + n) * D + hh * 128;
                f32x4 sacc[10];
                const int i = 16 * w + n;
#pragma unroll
                for (int kb = 0; kb < 9; ++kb) {
                    const int j0 = 16 * w + 16 * kb; const int r0 = ((((j0 >> 7) ^ par) & 1) << 7) + (j0 & 127);
                    f32x4 sv = (f32x4){0.f, 0.f, 0.f, 0.f};
#pragma unroll
                    for (int ks = 0; ks < 4; ++ks) { const bf16x8 kf = *(const LAS bf16x8*)(X.lds + (r0 + n) * KP + (32 * ks + 8 * q) * 2); sv = __builtin_amdgcn_mfma_f32_16x16x32_bf16(kf, qf[ks], sv, 0, 0, 0); }
                    const bool blk_ok = hp || (j0 >= 128);
#pragma unroll
                    for (int jj = 0; jj < 4; ++jj) { bool valid = blk_ok;
                        if (kb == 0) valid = valid && (4 * q + jj >= n);
                        if (kb == 8) valid = valid && (4 * q + jj <= n);
                        sv[jj] = valid ? sv[jj] : -INFINITY; }
                    sacc[kb] = sv;
                }
                float mx = -INFINITY;
#pragma unroll
                for (int kb = 0; kb < 9; ++kb)
#pragma unroll
                    for (int jj = 0; jj < 4; ++jj) mx = fmaxf(mx, sacc[kb][jj]);
                mx = fmaxf(mx, __shfl_xor(mx, 16)); mx = fmaxf(mx, __shfl_xor(mx, 32));
                const float sc2 = 0.08838834764831845f * 1.4426950408889634f; float l = 0.f;
#pragma unroll
                for (int kb = 0; kb < 9; ++kb)
#pragma unroll
                    for (int jj = 0; jj < 4; ++jj) { const float p = __builtin_amdgcn_exp2f((sacc[kb][jj] - mx) * sc2); sacc[kb][jj] = p; l += p; }
                sacc[9] = (f32x4){0.f, 0.f, 0.f, 0.f};
                l += __shfl_xor(l, 16); l += __shfl_xor(l, 32);
                f32x4 oacc[8];
#pragma unroll
                for (int eb = 0; eb < 8; ++eb) oacc[eb] = (f32x4){0.f, 0.f, 0.f, 0.f};
#pragma unroll
                for (int s2 = 0; s2 < 5; ++s2) {
                    const int ja = 16 * w + 32 * s2, jb = ja + 16; const int jac = ja > 240 ? 240 : ja, jbc = jb > 240 ? 240 : jb;
                    const int ca = ((((jac >> 7) ^ par) & 1) << 7) + (jac & 127), cbb = ((((jbc >> 7) ^ par) & 1) << 7) + (jbc & 127);
                    u32x4 pw; pw.x = cvt_pk_bf16(sacc[2 * s2][0], sacc[2 * s2][1]); pw.y = cvt_pk_bf16(sacc[2 * s2][2], sacc[2 * s2][3]);
                    pw.z = cvt_pk_bf16(sacc[2 * s2 + 1][0], sacc[2 * s2 + 1][1]); pw.w = cvt_pk_bf16(sacc[2 * s2 + 1][2], sacc[2 * s2 + 1][3]);
                    const bf16x8 pf = __builtin_bit_cast(bf16x8, pw);
#pragma unroll
                    for (int eb = 0; eb < 8; ++eb) { const int e = 16 * eb + n;
                        const u32x2 va = *(const LAS u32x2*)(X.lds + LDS_V + e * VP + (ca + 4 * q) * 2), vb = *(const LAS u32x2*)(X.lds + LDS_V + e * VP + (cbb + 4 * q) * 2);
                        const u32x4 vv = (u32x4){va.x, va.y, vb.x, vb.y};
                        oacc[eb] = __builtin_amdgcn_mfma_f32_16x16x32_bf16(__builtin_bit_cast(bf16x8, vv), pf, oacc[eb], 0, 0, 0); }
                }
                const float il = 1.0f / l; const float lse_own = mx * 0.08838834764831845f + __logf(l);
                const int ecol = (q & 1) ? 16 + 4 * (q - 1) : 4 * q;
                if (!fuse) {
#pragma unroll
                    for (int eb = 0; eb < 8; eb += 2) {
                        const unsigned a0 = cvt_pk_bf16(oacc[eb][0] * il, oacc[eb][1] * il), a1 = cvt_pk_bf16(oacc[eb][2] * il, oacc[eb][3] * il);
                        const unsigned b0 = cvt_pk_bf16(oacc[eb + 1][0] * il, oacc[eb + 1][1] * il), b1 = cvt_pk_bf16(oacc[eb + 1][2] * il, oacc[eb + 1][3] * il);
                        const auto s0 = __builtin_amdgcn_permlane16_swap(a0, b0, false, false), s1 = __builtin_amdgcn_permlane16_swap(a1, b1, false, false);
                        *(u32x4*)(qrow + 16 * eb + ecol) = (u32x4){s0[0], s1[0], s0[1], s1[1]}; }
                    if (q == 0) LSE[((size_t)g * SEQ + cb * 128 + i) * 16 + hh] = lse_own;
                } else {
                    const int c2 = cb * 128 + i, t = ((c2 & 1023) << 4) + (c2 >> 10), c1 = ((t & 3) << 12) + (t >> 2);
                    const float l0 = LSE[((size_t)0 * SEQ + t) * 16 + hh], l1 = LSE[((size_t)1 * SEQ + c1) * 16 + hh];
                    const bf16_t* o0 = ACT + (size_t)t * D + hh * 128 + ecol; const bf16_t* o1 = ACT + (size_t)3 * SEQ * D + (size_t)c1 * D + hh * 128 + ecol;
                    u32x4 a0[4], a1[4];
#pragma unroll
                    for (int ep = 0; ep < 4; ++ep) { a0[ep] = *(const u32x4*)(o0 + 32 * ep); a1[ep] = *(const u32x4*)(o1 + 32 * ep); }
                    const float mm = fmaxf(lse_own, fmaxf(l0, l1)); const float e0 = __expf(l0 - mm), e1 = __expf(l1 - mm), e2 = __expf(lse_own - mm);
                    const float iw = 1.0f / (e0 + e1 + e2); const float w0 = e0 * iw, w1 = e1 * iw, w2 = e2 * iw * il;
                    bf16_t* orow = Hb + (size_t)t * D + hh * 128 + ecol;
#pragma unroll
                    for (int ep = 0; ep < 4; ++ep) { const int eb = 2 * ep;
                        const auto p0x = __builtin_amdgcn_permlane16_swap(a0[ep].x, a0[ep].z, false, false), p0y = __builtin_amdgcn_permlane16_swap(a0[ep].y, a0[ep].w, false, false);
                        const auto p1x = __builtin_amdgcn_permlane16_swap(a1[ep].x, a1[ep].z, false, false), p1y = __builtin_amdgcn_permlane16_swap(a1[ep].y, a1[ep].w, false, false);
                        const unsigned r0 = cvt_pk_bf16(w0 * bf_lo(p0x[0]) + w1 * bf_lo(p1x[0]) + w2 * oacc[eb][0], w0 * bf_hi(p0x[0]) + w1 * bf_hi(p1x[0]) + w2 * oacc[eb][1]);
                        const unsigned r1 = cvt_pk_bf16(w0 * bf_lo(p0y[0]) + w1 * bf_lo(p1y[0]) + w2 * oacc[eb][2], w0 * bf_hi(p0y[0]) + w1 * bf_hi(p1y[0]) + w2 * oacc[eb][3]);
                        const unsigned r2 = cvt_pk_bf16(w0 * bf_lo(p0x[1]) + w1 * bf_lo(p1x[1]) + w2 * oacc[eb + 1][0], w0 * bf_hi(p0x[1]) + w1 * bf_hi(p1x[1]) + w2 * oacc[eb + 1][1]);
                        const unsigned r3 = cvt_pk_bf16(w0 * bf_lo(p0y[1]) + w1 * bf_lo(p1y[1]) + w2 * oacc[eb + 1][2], w0 * bf_hi(p0y[1]) + w1 * bf_hi(p1y[1]) + w2 * oacc[eb + 1][3]);
                        const auto s0 = __builtin_amdgcn_permlane16_swap(r0, r2, false, false), s1 = __builtin_amdgcn_permlane16_swap(r1, r3, false, false);
                        *(u32x4*)(orow + 32 * ep) = (u32x4){s0[0], s1[0], s0[1], s1[1]}; }
                }
            }
            __syncthreads();
        }
    }
}
__device__ __forceinline__ void combine_phase(const Ctx& X, const bf16_t* ACT, const float* LSE, bf16_t* Hb) {
    const int col = X.tid * 4, hh = X.tid >> 5;
    for (int s0 = blockIdx.x * 8; s0 < SEQ; s0 += X.G * 8) {
        float ls[8][3]; u32x2 ov[8][3];
#pragma unroll
        for (int r = 0; r < 8; ++r) { const int s = s0 + r;
#pragma unroll
            for (int g = 0; g < 3; ++g) { const int ld = 2 * g, lL = 14 - ld; const int c = ((s & ((1 << ld) - 1)) << lL) + (s >> ld);
                ls[r][g] = LSE[((size_t)g * SEQ + c) * 16 + hh]; ov[r][g] = *(const u32x2*)(ACT + (size_t)(g * 3) * SEQ * D + (size_t)c * D + col); } }
#pragma unroll
        for (int r = 0; r < 8; ++r) { const int s = s0 + r;
            const float mx = fmaxf(ls[r][0], fmaxf(ls[r][1], ls[r][2])); float wg[3], wsum = 0.f;
#pragma unroll
            for (int g = 0; g < 3; ++g) { wg[g] = __expf(ls[r][g] - mx); wsum += wg[g]; }
            const float iw = 1.0f / wsum; float o[4] = {0.f, 0.f, 0.f, 0.f};
#pragma unroll
            for (int g = 0; g < 3; ++g) { const float ww = wg[g] * iw; o[0] += ww * bf_lo(ov[r][g].x); o[1] += ww * bf_hi(ov[r][g].x); o[2] += ww * bf_lo(ov[r][g].y); o[3] += ww * bf_hi(ov[r][g].y); }
            u32x2 rr; rr.x = cvt_pk_bf16(o[0], o[1]); rr.y = cvt_pk_bf16(o[2], o[3]); *(u32x2*)(Hb + (size_t)s * D + col) = rr; }
    }
}

__global__ void __launch_bounds__(NT, 2) fwd_megakernel(Args a) {
    extern __shared__ __attribute__((aligned(16))) unsigned char lds_raw[];
    cg::grid_group grid = cg::this_grid();
    Ctx X; X.G = gridDim.x; X.ngw = X.G * 8; X.lds = (LAS unsigned char*)lds_raw;
#define REFRESH() do { int t_ = threadIdx.x; asm volatile("" : "+v"(t_)); int bx_ = blockIdx.x; asm volatile("" : "+s"(bx_)); X.tid = t_; X.lane = t_ & 63; X.wave = __builtin_amdgcn_readfirstlane(t_ >> 6); \
        X.vcu = (X.G % 8 == 0) ? (bx_ % 8) * (X.G / 8) + bx_ / 8 : bx_; X.gw = bx_ * 8 + X.wave; } while (0)
    REFRESH();
    unsigned char* ws = a.ws;
    bf16_t* Wt = (bf16_t*)(ws + WS_W); bf16_t* H = (bf16_t*)(ws + WS_H); bf16_t* ACT = (bf16_t*)(ws + WS_ACT);
    float* MOD = (float*)(ws + WS_MOD); float* L2G = (float*)(ws + WS_L2G); f32x2* STATS = (f32x2*)(ws + WS_STATS); float* LSE = (float*)(ws + WS_LSE);
    using namespace pg8;
#define SYNC() xcd_barrier(xbar)

    { volatile LAS unsigned* st = (volatile LAS unsigned*)(X.lds + LDS_MISC); if (X.tid < 4) st[X.tid] = 0u; __syncthreads(); }
    XcdBarrier xbar = xcd_barrier_post((unsigned*)(ws + WS_BAR), (volatile LAS unsigned*)(X.lds + LDS_MISC));
    { LAS float* tab = (LAS float*)(X.lds + 131072);
      if (X.tid < 144) tab[X.tid] = X.tid < 128 ? a.invf_ret[X.tid] : a.invf_att[X.tid - 128];
      if (blockIdx.x == 0 && X.tid < 8) L2G[X.tid] = a.l2g[X.tid];
      __syncthreads(); }

    tables_phase(X, a);
    modp_phase(X, a);
    grid.sync();
    modfin_phase(X, a);

#pragma unroll 1
    for (int layer = 0; layer < 2; ++layer) {
        REFRESH();
        const float* MODL = MOD + (size_t)layer * 2 * 12288;
        { int base = 0;
          if (layer == 0) { transpose_items(X, a.ret_w_in, D, RPROJ, Wt + W0_RIN, base); transpose_items(X, a.ret_w_out, RV, D, Wt + W0_ROUT, base); }
          else            { transpose_items(X, a.att_w_in, D, APROJ, Wt + W1_AIN, base); transpose_items(X, a.att_w_out, D, D, Wt + W1_AOUT, base); }
          const size_t w1o = layer == 0 ? W0_1 : W1_1, w2o = layer == 0 ? W0_2 : W1_2;
          transpose_items(X, a.mlp_w1 + (size_t)layer * D * DFF, D, DFF, Wt + w1o, base);
          transpose_items(X, a.mlp_w2 + (size_t)layer * D * DFF, DFF, D, Wt + w2o, base); }
        SYNC();
        const float* xin = layer == 0 ? a.x : a.out;
        if (layer == 0) {
#pragma unroll 1
            for (int b = 0; b < NB; ++b) {
                REFRESH();
                bf16_t* Hb = H + (size_t)b * SEQ * D;
                if (b == 0) { norm_mod_phase(X, xin, a.norm_mix, MODL, 0, H, 0, T); SYNC(); }
                const f32x4* csr = (const f32x4*)(ws + WS_CSR + (size_t)b * SEQ * 128 * 8); const f32x4* csrt = (const f32x4*)(ws + WS_CSRT + (size_t)b * SEQ * 128 * 8);
#pragma unroll 1
                for (int qk = 0; qk < 2; ++qk) {
                    Gemm g{Hb, Wt + W0_RIN + (size_t)qk * 2048 * D, D, D, D}; auto S = mk_sched(64, 8, MapRetQK{qk == 0 ? 131072u : 65536u});
                    EpiRetQK E{ACT + (qk == 0 ? A_AP : A_KT), qk == 0 ? 512 : 256, csr, qk, L2G, ACT + A_KZ};
                    gemm_phase(X.lds, g, S, E); }
                {
                    Gemm g{Wt + W0_RIN + (size_t)4096 * D, Hb, D, D, D}; auto S = mk_sched(16, 64, MapVT0{});
                    EpiBf16<0> E{ACT + A_BP, 512}; gemm_phase(X.lds, g, S, E); }
                SYNC();
                {
                    Gemm g{ACT + A_AP, ACT + A_KT, 512, 256, 256}; auto S = mk_sched(512, 1, MapP{});
                    EpiP E{ACT + A_AP, L2G};
                    gemm_phase(X.lds, g, S, E); }
                {
                    Gemm g{ACT + A_BP, ACT + A_KZ, 512, 256, 256}; auto S = mk_sched(1024, 1, MapU{});
                    EpiBf16<0> E{ACT + A_BP, 512}; gemm_phase(X.lds, g, S, E); }
                SYNC();
                scan_phase(X, ACT + A_BP, L2G);
                SYNC();
                {
                    Gemm g{ACT + A_AP, ACT + A_BP, 512, 512, 512}; auto S = mk_sched(512, 2, MapO{});
                    EpiO E{ACT + A_O, STATS}; gemm_phase(X.lds, g, S, E); }
                SYNC();
                {
                    Gemm g{Hb, Wt + W0_RIN + (size_t)8192 * D, D, D, D}; auto S = mk_sched(64, 16, MapG{});
                    EpiGate E{ACT + A_GG, ACT + A_O, STATS}; gemm_phase(X.lds, g, S, E); }
                SYNC();
                {
                    Gemm g{ACT + A_GG, Wt + W0_ROUT, RV, RV, RV}; auto S = mk_sched(64, 8, MapOut0{});
                    EpiRes E{a.x + (size_t)b * SEQ * D, a.out + (size_t)b * SEQ * D, MODL + (size_t)b * 12288 + 2 * D, 0}; gemm_phase(X.lds, g, S, E); }
                if (b == NB - 1) SYNC();
            }
        } else {
#pragma unroll 1
            for (int b = 0; b < NB; ++b) {
                REFRESH();
                bf16_t* Hb = H + (size_t)b * SEQ * D;
                if (b == 0) { norm_mod_phase(X, xin, a.norm_mix + D, MODL, 0, H, 0, T); SYNC(); }
                const f32x4* csa = (const f32x4*)(ws + WS_CSA + (size_t)b * SEQ * 16 * 8);
#pragma unroll 1
                for (int gq = 0; gq < 6; ++gq) {
                    const int gi = gq >> 1, qk = gq & 1, ld = 2 * gi, lL = 14 - ld, dil = 1 << ld;
                    Gemm g{Hb, Wt + W1_AIN + (size_t)(gi * 6144 + qk * 2048) * D, dil * D, D, D}; auto S = mk_sched(64, 8, MapAttQK{6 - ld, ld});
                    EpiAttQK E{ACT + (size_t)(gi * 3 + qk) * SEQ * D, csa, ld, lL}; gemm_phase(X.lds, g, S, E); }
#pragma unroll 1
                for (int gi = 0; gi < 3; ++gi) {
                    const int ld = 2 * gi, dil = 1 << ld;
                    Gemm g{Wt + W1_AIN + (size_t)(gi * 6144 + 4096) * D, Hb, D, dil * D, D}; auto S = mk_sched(8, 64, MapAttVT{6 - ld, ld});
                    EpiBf16<0> E{ACT + (size_t)(gi * 3 + 2) * SEQ * D, SEQ}; gemm_phase(X.lds, g, S, E); }
                SYNC();
#pragma unroll 1
                for (int ap = 0; ap < 2; ++ap) {
                    REFRESH();
                    attn_phase(X, ACT, LSE, Hb, ap == 0 ? 0 : 2, ap == 0 ? 2 : 3, ap == 1);
                    SYNC(); }
            }
            { Gemm g{H, Wt + W1_AOUT, D, D, D}; auto S = mk_sched(128, 8, MapOut1{});
              EpiRes E{a.out, a.out, MODL + 2 * D, 12288}; gemm_phase(X.lds, g, S, E); }
            SYNC();
        }
        norm_mod_phase(X, a.out, a.norm_mlp + layer * D, MODL, 3, H, 0, T);
        SYNC();
        { Gemm g{H, Wt + (layer == 0 ? W0_1 : W1_1), D, D, D}; auto S = mk_sched(128, 32, MapMlp1{});
          EpiBf16<2> E{ACT, DFF}; gemm_phase(X.lds, g, S, E);
#ifdef PROBE_A
          SYNC(); gemm_phase(X.lds, g, S, E);
#endif
        }
        SYNC();
        { Gemm g{ACT, Wt + (layer == 0 ? W0_2 : W1_2), DFF, DFF, DFF}; auto S = mk_sched(128, 8, MapMlp2{});
          if (layer == 0) { EpiRes E{a.out, a.out, MODL + 5 * D, 12288}; gemm_phase(X.lds, g, S, E); }
          else { EpiY E{H, MODL + 5 * D, 12288}; gemm_phase(X.lds, g, S, E); } }
        SYNC();
    }
    final_norm_phase(X, a.out, H, a.final_norm);
}

extern "C" void kernel_launch(void* const* d_in, const int* in_sizes, int n_in, void* d_out, int out_size, void* d_ws, size_t ws_size, hipStream_t stream) {
    static int grid = 0;
    if (grid == 0) {
        if (n_in != 14 || out_size != T * D || ws_size < WS_END) { fprintf(stderr, "kernel_launch: unexpected shapes (n_in %d out %d ws %zu need %zu)\n", n_in, out_size, ws_size, (size_t)WS_END); grid = -1; return; }
        int dev = 0, cus = 0, per_cu = 0;
        hipGetDevice(&dev); hipDeviceGetAttribute(&cus, hipDeviceAttributeMultiprocessorCount, dev);
        if (hipFuncSetAttribute((const void*)fwd_megakernel, hipFuncAttributeMaxDynamicSharedMemorySize, LDS_BYTES) != hipSuccess) { fprintf(stderr, "kernel_launch: hipFuncSetAttribute failed\n"); grid = -1; return; }
        hipOccupancyMaxActiveBlocksPerMultiprocessor(&per_cu, (const void*)fwd_megakernel, NT, LDS_BYTES);
        if (per_cu < 1) { fprintf(stderr, "kernel_launch: occupancy query says %d blocks/CU\n", per_cu); per_cu = 1; }
        grid = cus;
    }
    if (grid < 0) return;
    Args a{};
    a.x = (const float*)d_in[0]; a.c = (const float*)d_in[1]; a.pos = (const int*)d_in[2]; a.ada_w = (const float*)d_in[3]; a.ada_b = (const float*)d_in[4];
    a.norm_mix = (const float*)d_in[5]; a.norm_mlp = (const float*)d_in[6]; a.ret_w_in = (const float*)d_in[7]; a.ret_w_out = (const float*)d_in[8];
    a.att_w_in = (const float*)d_in[9]; a.att_w_out = (const float*)d_in[10]; a.mlp_w1 = (const float*)d_in[11]; a.mlp_w2 = (const float*)d_in[12]; a.final_norm = (const float*)d_in[13];
    a.out = (float*)d_out; a.ws = (unsigned char*)d_ws;
    for (int d = 0; d < 128; ++d) a.invf_ret[d] = (float)pow(10000.0, -(double)d / 128.0);
    for (int d = 0; d < 16; ++d) a.invf_att[d] = (float)pow(500000.0, -(double)d / 16.0);
    for (int h = 0; h < 8; ++h) a.l2g[h] = (float)log2(1.0 - exp2(-5.0 - (double)h));
    if (hipMemsetAsync((char*)d_ws + WS_BAR, 0, BAR_BYTES, stream) != hipSuccess) { fprintf(stderr, "kernel_launch: memset failed\n"); return; }
    void* args[] = {&a};
    hipError_t e = hipLaunchCooperativeKernel((const void*)fwd_megakernel, dim3(grid), dim3(NT), args, LDS_BYTES, stream);
    if (e != hipSuccess) fprintf(stderr, "cooperative launch failed: %s (grid %d)\n", hipGetErrorString(e), grid);
}
```
